# Optimizing an MI355X kernel written in HIP

```python
import jax
import jax.numpy as jnp
from jax import lax
import numpy as np

D_MODEL = 2048
BATCH = 1
SEQ = 8192
DEPTH = 4
DEC_BATCH = 8
DEC_SEQ = 4096
PAST_LEN = 128

HEAD_DIM = 128
A_Q_HEADS = 8
A_KV_HEADS = 2
B_Q_HEADS = 8
B_KV_HEADS = 2
A_Q_W = A_Q_HEADS * HEAD_DIM
A_KV_W = A_KV_HEADS * HEAD_DIM
B_Q_W = B_Q_HEADS * HEAD_DIM
B_KV_W = B_KV_HEADS * HEAD_DIM
IN_W = A_Q_W + 2 * A_KV_W + B_Q_W + 2 * B_KV_W + 2 * D_MODEL
WINDOW = 128
BLOCK = 128
GRID_W = 64
ROPE_THETA = 10000.0
D_FF = ((8 * D_MODEL + 3 * 256 - 1) // (3 * 256)) * 256
N_MOD = 6
EPS = 1e-6
MASK_VALUE = -1e30

kernel_name = "hybrid_gated_window_axial_encoder"


def rms_norm(x, g):
    xf = x.astype(jnp.float32)
    y = xf * lax.rsqrt(jnp.mean(xf * xf, axis=-1, keepdims=True) + EPS)
    return (y * g.astype(jnp.float32)).astype(x.dtype)


def rope_angles(pos, dim):
    inv_freq = ROPE_THETA ** (-jnp.arange(0, dim, 2, dtype=jnp.float32) / dim)
    ang = pos.astype(jnp.float32)[:, None] * inv_freq[None, :]
    return jnp.cos(ang), jnp.sin(ang)


def apply_rotary(x, cos, sin):
    c = cos[None, :, None, :].astype(x.dtype)
    s = sin[None, :, None, :].astype(x.dtype)
    x1, x2 = jnp.split(x, 2, axis=-1)
    return jnp.concatenate([x1 * c - x2 * s, x2 * c + x1 * s], axis=-1)


def apply_axial_rotary(x, cos_r, sin_r, cos_c, sin_c):
    xr, xc = jnp.split(x, 2, axis=-1)
    return jnp.concatenate([apply_rotary(xr, cos_r, sin_r), apply_rotary(xc, cos_c, sin_c)], axis=-1)


def window_attention(q, k, v, sink):
    B, S, Hq, Dh = q.shape
    Hkv = k.shape[2]
    G = Hq // Hkv
    nb = S // BLOCK
    pad = ((0, 0), (BLOCK, BLOCK), (0, 0), (0, 0))
    kp = jnp.pad(k, pad).reshape(B, nb + 2, BLOCK, Hkv, Dh)
    vp = jnp.pad(v, pad).reshape(B, nb + 2, BLOCK, Hkv, Dh)
    kb = jnp.concatenate([kp[:, :-2], kp[:, 1:-1], kp[:, 2:]], axis=2)
    vb = jnp.concatenate([vp[:, :-2], vp[:, 1:-1], vp[:, 2:]], axis=2)
    qb = q.reshape(B, nb, BLOCK, Hkv, G, Dh)
    s = jnp.einsum('bnqhgd,bnkhd->bnhgqk', qb, kb).astype(jnp.float32) * (Dh ** -0.5)
    qpos = jnp.arange(nb)[:, None] * BLOCK + jnp.arange(BLOCK)[None, :]
    kpos = jnp.arange(nb)[:, None] * BLOCK - BLOCK + jnp.arange(3 * BLOCK)[None, :]
    valid = ((jnp.abs(qpos[:, :, None] - kpos[:, None, :]) <= WINDOW)
             & (kpos[:, None, :] >= 0) & (kpos[:, None, :] < S))
    s = jnp.where(valid[None, :, None, None], s, MASK_VALUE)
    sink_l = sink.astype(jnp.float32).reshape(Hkv, G)[None, None, :, :, None, None]
    m = jnp.maximum(jnp.max(s, axis=-1, keepdims=True), sink_l)
    p = jnp.exp(s - m)
    denom = jnp.sum(p, axis=-1, keepdims=True) + jnp.exp(sink_l - m)
    p = (p / denom).astype(v.dtype)
    o = jnp.einsum('bnhgqk,bnkhd->bnqhgd', p, vb)
    return o.reshape(B, S, Hq * Dh)


def dense_attention(q, k, v):
    B, S, Hq, Dh = q.shape
    Hkv = k.shape[2]
    G = Hq // Hkv
    nb = S // BLOCK
    qb = q.reshape(B, nb, BLOCK, Hkv, G, Dh).transpose(1, 0, 2, 3, 4, 5)

    def one_block(qi):
        s = jnp.einsum('bqhgd,bkhd->bhgqk', qi, k).astype(jnp.float32) * (Dh ** -0.5)
        p = jax.nn.softmax(s, axis=-1).astype(v.dtype)
        return jnp.einsum('bhgqk,bkhd->bqhgd', p, v)

    o = lax.map(one_block, qb)
    return o.transpose(1, 0, 2, 3, 4, 5).reshape(B, S, Hq * Dh)


def encoder_layer(x, c, rope1d, rope_axial, g_pre_mix, g_post_mix, g_pre_ffn, g_post_ffn, w_mod, b_mod,
                  w_in, q_norm_b, k_norm_b, sink_a, w_branch_a, w_branch_b, w_out, w_13, w_2):
    B, S, _ = x.shape
    cos1, sin1 = rope1d
    cos_r, sin_r, cos_c, sin_c = rope_axial
    mod = jax.nn.silu(c) @ w_mod + b_mod
    shift_m, scale_m, gate_m, shift_f, scale_f, gate_f = [m[:, None, :] for m in jnp.split(mod, N_MOD, axis=-1)]

    u = rms_norm(x, g_pre_mix) * (1 + scale_m) + shift_m
    z = u @ w_in
    idx = np.cumsum([A_Q_W, A_KV_W, A_KV_W, B_Q_W, B_KV_W, B_KV_W, D_MODEL]).tolist()
    qa, ka, va, qb, kb, vb, ga, gb = jnp.split(z, idx, axis=-1)

    def heads(t, h):
        return t.reshape(B, S, h, HEAD_DIM)

    oa = window_attention(apply_rotary(heads(qa, A_Q_HEADS), cos1, sin1),
                          apply_rotary(heads(ka, A_KV_HEADS), cos1, sin1),
                          heads(va, A_KV_HEADS), sink_a)
    qbh = apply_axial_rotary(rms_norm(heads(qb, B_Q_HEADS), q_norm_b), cos_r, sin_r, cos_c, sin_c)
    kbh = apply_axial_rotary(rms_norm(heads(kb, B_KV_HEADS), k_norm_b), cos_r, sin_r, cos_c, sin_c)
    ob = dense_attention(qbh, kbh, heads(vb, B_KV_HEADS))

    merged = jax.nn.sigmoid(ga) * (oa @ w_branch_a) + jax.nn.sigmoid(gb) * (ob @ w_branch_b)
    y = merged @ w_out
    x = x + gate_m * rms_norm(y, g_post_mix)

    u = rms_norm(x, g_pre_ffn) * (1 + scale_f) + shift_f
    h1, h3 = jnp.split(u @ w_13, 2, axis=-1)
    y = (jax.nn.silu(h1) * h3) @ w_2
    return x + gate_f * rms_norm(y, g_post_ffn)


def encoder(x, c, g_pre_mix, g_post_mix, g_pre_ffn, g_post_ffn, w_mod, b_mod, w_in, q_norm_b, k_norm_b,
            sink_a, w_branch_a, w_branch_b, w_out, w_13, w_2):
    S = x.shape[1]
    rows = S // GRID_W
    t = jnp.arange(S)
    row = jnp.repeat(jnp.arange(rows), GRID_W)
    col = jnp.tile(jnp.arange(GRID_W), rows)
    rope1d = rope_angles(t, HEAD_DIM)
    cos_r, sin_r = rope_angles(row, HEAD_DIM // 2)
    cos_c, sin_c = rope_angles(col, HEAD_DIM // 2)
    rope_axial = (cos_r, sin_r, cos_c, sin_c)
    for l in range(DEPTH):
        x = encoder_layer(x, c, rope1d, rope_axial, g_pre_mix[l], g_post_mix[l], g_pre_ffn[l], g_post_ffn[l],
                          w_mod[l], b_mod[l], w_in[l], q_norm_b[l], k_norm_b[l], sink_a[l],
                          w_branch_a[l], w_branch_b[l], w_out[l], w_13[l], w_2[l])
    return x


def setup_inputs(seed: int = 0) -> dict:
    key = jax.random.key(seed)
    ks = jax.random.split(key, 20)

    def nrm(k, shape, std):
        return jax.random.normal(k, shape, jnp.float32) * std

    def gain(k, shape):
        return 1.0 + 0.05 * jax.random.normal(k, shape, jnp.float32)

    return {
        "x_prompt": nrm(ks[0], (BATCH, SEQ, D_MODEL), 1.0),
        "x_sample": nrm(ks[1], (DEC_BATCH, DEC_SEQ, D_MODEL), 1.0),
        "c_prompt": nrm(ks[2], (BATCH, D_MODEL), 1.0),
        "c_sample": nrm(ks[3], (DEC_BATCH, D_MODEL), 1.0),
        "g_pre_mix": gain(ks[4], (DEPTH, D_MODEL)),
        "g_post_mix": gain(ks[5], (DEPTH, D_MODEL)),
        "g_pre_ffn": gain(ks[6], (DEPTH, D_MODEL)),
        "g_post_ffn": gain(ks[7], (DEPTH, D_MODEL)),
        "w_mod": nrm(ks[8], (DEPTH, D_MODEL, N_MOD * D_MODEL), 0.5 * D_MODEL ** -0.5),
        "b_mod": nrm(ks[9], (DEPTH, N_MOD * D_MODEL), 0.02),
        "w_in": nrm(ks[10], (DEPTH, D_MODEL, IN_W), D_MODEL ** -0.5),
        "q_norm_b": gain(ks[11], (DEPTH, HEAD_DIM)),
        "k_norm_b": gain(ks[12], (DEPTH, HEAD_DIM)),
        "sink_a": nrm(ks[13], (DEPTH, A_Q_HEADS), 0.5),
        "w_branch_a": nrm(ks[14], (DEPTH, A_Q_W, D_MODEL), A_Q_W ** -0.5),
        "w_branch_b": nrm(ks[15], (DEPTH, B_Q_W, D_MODEL), B_Q_W ** -0.5),
        "w_out": nrm(ks[16], (DEPTH, D_MODEL, D_MODEL), D_MODEL ** -0.5),
        "w_13": nrm(ks[17], (DEPTH, D_MODEL, 2 * D_FF), D_MODEL ** -0.5),
        "w_2": nrm(ks[18], (DEPTH, D_FF, D_MODEL), D_FF ** -0.5),
    }


def reference(x_prompt, x_sample, c_prompt, c_sample, g_pre_mix, g_post_mix, g_pre_ffn, g_post_ffn, w_mod, b_mod,
              w_in, q_norm_b, k_norm_b, sink_a, w_branch_a, w_branch_b, w_out, w_13, w_2):
    y_prompt = encoder(x_prompt, c_prompt, g_pre_mix, g_post_mix, g_pre_ffn, g_post_ffn, w_mod, b_mod, w_in,
                       q_norm_b, k_norm_b, sink_a, w_branch_a, w_branch_b, w_out, w_13, w_2)
    y_sample = encoder(x_sample, c_sample, g_pre_mix, g_post_mix, g_pre_ffn, g_post_ffn, w_mod, b_mod, w_in,
                       q_norm_b, k_norm_b, sink_a, w_branch_a, w_branch_b, w_out, w_13, w_2)
    return (y_prompt, y_sample)
```

```cpp
#include <hip/hip_runtime.h>
#include <cstdio>
#include <cstdint>
namespace pg8 {
#define PG8_LAS __attribute__((address_space(3)))
typedef unsigned short bf16_t;
typedef short bf16x8 __attribute__((ext_vector_type(8)));
typedef float f32x4 __attribute__((ext_vector_type(4)));
typedef unsigned u32x4 __attribute__((ext_vector_type(4)));
constexpr int BM = 256, BK = 64, HALF = 128, HTB = HALF * BK * 2  , STAGE_BYTES = 8 * HTB, NXCD = 8, WGM = 8;

__host__ __device__ __forceinline__ int lds_byte(int r, int c) { const int st = (r >> 4) * 2 + (c >> 5), rr = r & 15, cc = c & 31, ob = rr * 64 + cc * 2; return st * 1024 + (ob ^ (((ob >> 9) & 1) << 5)); }
__host__ __device__ __forceinline__ void stage_rc(int b, int& R, int& C) { const int st = b / 1024, sb = b % 1024, swz = sb ^ (((sb >> 9) & 1) << 5); R = (st >> 1) * 16 + swz / 64; C = (st & 1) * 32 + (swz % 64) / 2; }
__host__ __device__ __forceinline__ int perm32(int rho) { const int n = rho >> 4, i = rho & 15; return 8 * (i >> 2) + 4 * n + (i & 3); }

struct Unit { int pm, pn; };
struct Gemm { const bf16_t* A; const bf16_t* Bt; int M, N, K; };

struct StaticOrder {
    int nM, nN, nwg, G, c;
    __host__ __device__ void init(int M, int N, int G_, int c_) { nM = M / BM; nN = N / BM; nwg = nM * nN; G = G_; c = c_; }
    __host__ __device__ bool next(int i, Unit& u) const {
        const long L = (long)i * G + c; if (L >= nwg) return false;
        int wgid = (int)L; { const int q = nwg / NXCD, r = nwg % NXCD, xcd = wgid % NXCD, off = wgid / NXCD; wgid = (xcd < r ? xcd * (q + 1) : r * (q + 1) + (xcd - r) * q) + off; }
        const int nig = WGM * nN, gid = wgid / nig, fm = gid * WGM, gsz = (nM - fm) < WGM ? (nM - fm) : WGM;
        u.pm = fm + ((wgid % nig) % gsz); u.pn = (wgid % nig) / gsz; return true;
    }
    __device__ __forceinline__ void a_ready(const Unit&) const {}
    __device__ __forceinline__ void done(const Unit&) const {}
};
__device__ __forceinline__ unsigned cvt_pk_bf16(float lo, float hi) { unsigned r; asm volatile("v_cvt_pk_bf16_f32 %0, %1, %2" : "=v"(r) : "v"(lo), "v"(hi)); return r; }
typedef float f32x2 __attribute__((ext_vector_type(2)));
typedef unsigned u32x2 __attribute__((ext_vector_type(2)));
__device__ __forceinline__ float bf_lo(unsigned w) { return __uint_as_float(w << 16); }
__device__ __forceinline__ float bf_hi(unsigned w) { return __uint_as_float(w & 0xffff0000u); }
__device__ __forceinline__ float sigmoid_f(float x) { return __builtin_amdgcn_rcpf(1.0f + __builtin_amdgcn_exp2f(x * -1.4426950408889634f)); }
__device__ __forceinline__ u32x4 pack8(const f32x4 v0, const f32x4 v1) { u32x4 w; w.x = cvt_pk_bf16(v0[0], v0[1]); w.y = cvt_pk_bf16(v0[2], v0[3]); w.z = cvt_pk_bf16(v1[0], v1[1]); w.w = cvt_pk_bf16(v1[2], v1[3]); return w; }
__device__ __forceinline__ void unpack8(const u32x4 w, f32x4& v0, f32x4& v1) { v0 = (f32x4){bf_lo(w.x), bf_hi(w.x), bf_lo(w.y), bf_hi(w.y)}; v1 = (f32x4){bf_lo(w.z), bf_hi(w.z), bf_lo(w.w), bf_hi(w.w)}; }

struct EpiPlain {
    static constexpr bool PERM = true, AFTER_DRAIN = false, HAS_MID = false;
    bf16_t* O; int ldc;
    __device__ __forceinline__ void operator()(const f32x4 (&acc)[2][2][4][2], const Unit& u, int wr, int wc, int fr, int fq) const {
        const int row0 = u.pm * BM + wr * 64 + fr, col0 = u.pn * BM + wc * 32 + 8 * fq;
#pragma unroll
        for (int ai = 0; ai < 2; ++ai)
#pragma unroll
            for (int m = 0; m < 4; ++m) { bf16_t* rowp = O + (size_t)(row0 + ai * HALF + m * 16) * ldc + col0;
#pragma unroll
                for (int bj = 0; bj < 2; ++bj) *(u32x4*)(rowp + bj * HALF) = pack8(acc[ai][bj][m][0], acc[ai][bj][m][1]); }
    }
};
struct EpiSwiglu {
    static constexpr bool PERM = true, AFTER_DRAIN = false, HAS_MID = false;
    bf16_t* O; int ldc;
    __device__ __forceinline__ void operator()(const f32x4 (&acc)[2][2][4][2], const Unit& u, int wr, int wc, int fr, int fq) const {
        const int row0 = u.pm * BM + wr * 64 + fr, col0 = u.pn * HALF + wc * 32 + 8 * fq;
#pragma unroll
        for (int ai = 0; ai < 2; ++ai)
#pragma unroll
            for (int m = 0; m < 4; ++m) { bf16_t* rowp = O + (size_t)(row0 + ai * HALF + m * 16) * ldc + col0;
                f32x4 h[2];
#pragma unroll
                for (int n = 0; n < 2; ++n) { const f32x4 a = acc[ai][0][m][n], b = acc[ai][1][m][n];
#pragma unroll
                    for (int j = 0; j < 4; ++j) h[n][j] = a[j] * sigmoid_f(a[j]) * b[j]; }
                *(u32x4*)rowp = pack8(h[0], h[1]); }
    }
};
struct EpiMerge {
    static constexpr bool PERM = true, AFTER_DRAIN = false, HAS_MID = true;
    bf16_t* O; int ldc; int mid_t; const bf16_t* Z; int ldz; int ga_off, gb_off;
    __device__ __forceinline__ void mid(f32x4 (&acc)[2][2][4][2], const Unit& u, int wr, int wc, int fr, int fq) const {
        int row0 = u.pm * BM + wr * 64 + fr, col0 = u.pn * BM + wc * 32 + 8 * fq;
        asm volatile("" : "+v"(row0), "+v"(col0));
#pragma unroll
        for (int ai = 0; ai < 2; ++ai)
#pragma unroll
            for (int m = 0; m < 4; ++m) { const bf16_t* zr = Z + (size_t)(row0 + ai * HALF + m * 16) * ldz + col0;
#pragma unroll
                for (int bj = 0; bj < 2; ++bj) { const u32x4 wa = *(const u32x4*)(zr + ga_off + bj * HALF), wb = *(const u32x4*)(zr + gb_off + bj * HALF);
                    f32x4 a0, a1, b0, b1; unpack8(wa, a0, a1); unpack8(wb, b0, b1);
#pragma unroll
                    for (int j = 0; j < 4; ++j) {
                        acc[ai][bj][m][0][j] *= (1.0f + __builtin_amdgcn_exp2f(b0[j] * -1.4426950408889634f)) * __builtin_amdgcn_rcpf(1.0f + __builtin_amdgcn_exp2f(a0[j] * -1.4426950408889634f));
                        acc[ai][bj][m][1][j] *= (1.0f + __builtin_amdgcn_exp2f(b1[j] * -1.4426950408889634f)) * __builtin_amdgcn_rcpf(1.0f + __builtin_amdgcn_exp2f(a1[j] * -1.4426950408889634f)); } }
                asm volatile("" : "+v"(acc[ai][0][m][0]), "+v"(acc[ai][0][m][1]), "+v"(acc[ai][1][m][0]), "+v"(acc[ai][1][m][1]) :: "memory"); }
    }
    __device__ __forceinline__ void operator()(const f32x4 (&acc)[2][2][4][2], const Unit& u, int wr, int wc, int fr, int fq) const {
        const int row0 = u.pm * BM + wr * 64 + fr, col0 = u.pn * BM + wc * 32 + 8 * fq;
#pragma unroll
        for (int ai = 0; ai < 2; ++ai)
#pragma unroll
            for (int m = 0; m < 4; ++m) { const size_t r = (size_t)(row0 + ai * HALF + m * 16); const bf16_t* zr = Z + r * ldz + col0 + gb_off; bf16_t* rowp = O + r * ldc + col0;
#pragma unroll
                for (int bj = 0; bj < 2; ++bj) { const u32x4 wb = *(const u32x4*)(zr + bj * HALF); f32x4 b0, b1; unpack8(wb, b0, b1); f32x4 v0, v1;
#pragma unroll
                    for (int j = 0; j < 4; ++j) { v0[j] = acc[ai][bj][m][0][j] * sigmoid_f(b0[j]); v1[j] = acc[ai][bj][m][1][j] * sigmoid_f(b1[j]); }
                    *(u32x4*)(rowp + bj * HALF) = pack8(v0, v1); } }
    }
};

template <class Epi, class Sched, bool ALIGN_EPI = false, bool SP2 = false>
__device__ __forceinline__ void gemm_phase(PG8_LAS unsigned char* lds, const Gemm g, const Sched& S, const Epi& E) {
    int tid = threadIdx.x; asm volatile("" : "+v"(tid));
    const int wid = __builtin_amdgcn_readfirstlane(tid >> 6), lane = tid & 63, wr = wid >> 2, wc = wid & 3, fr = lane & 15, fq = lane >> 4;
    const int K = g.K, nt = K / BK;
    unsigned voffA[2], voffB[2];
#pragma unroll
    for (int i = 0; i < 2; ++i) { int R, C; stage_rc(tid * 16 + i * 8192, R, C); const int Rb = Epi::PERM ? ((R & ~31) + perm32(R & 31)) : R;
        voffA[i] = (unsigned)(R * K + C) * 2u; voffB[i] = (unsigned)(Rb * K + C) * 2u; }
    const size_t kstep = (size_t)(BK * 2);
    const size_t hstep = (size_t)HALF * K * 2;
    const size_t tstep = 2 * hstep;
    const unsigned ldsw = (unsigned)wid * 1024u;
    const int aoff = lds_byte(wr * 64 + fr, fq * 8), boff = lds_byte(wc * 32 + fr, fq * 8);
#define PG8_SA(b, h) (((b) * 2 + (h)) * HTB)
#define PG8_SB(b, h) ((4 + (b) * 2 + (h)) * HTB)
#define PG8_STAGE(bufoff, gbase, voff) do { _Pragma("unroll") for (int _i = 0; _i < 2; ++_i) \
        __builtin_amdgcn_global_load_lds((const unsigned*)((const char*)(gbase) + (voff)[_i]), (PG8_LAS unsigned*)(lds + (bufoff) + ldsw + _i * 8192), 16, 0, 0); } while (0)
#define PG8_LDA(dst, b, h) do { _Pragma("unroll") for (int m = 0; m < 4; ++m) _Pragma("unroll") for (int k = 0; k < 2; ++k) dst[m][k] = *(const PG8_LAS bf16x8*)(lds + PG8_SA(b, h) + aoff + m * 2048 + k * 1024); } while (0)
#define PG8_LDB(dst, b, h) do { _Pragma("unroll") for (int n = 0; n < 2; ++n) _Pragma("unroll") for (int k = 0; k < 2; ++k) dst[n][k] = *(const PG8_LAS bf16x8*)(lds + PG8_SB(b, h) + boff + n * 2048 + k * 1024); } while (0)
#define PG8_MMA(ai, bj, At, Bt) do { __builtin_amdgcn_s_setprio(1); _Pragma("unroll") for (int m = 0; m < 4; ++m) _Pragma("unroll") for (int n = 0; n < 2; ++n) _Pragma("unroll") for (int k = 0; k < 2; ++k) \
        acc[ai][bj][m][n] = __builtin_amdgcn_mfma_f32_16x16x32_bf16(Bt[n][k], At[m][k], acc[ai][bj][m][n], 0, 0, 0); __builtin_amdgcn_s_setprio(0); } while (0)
#define PG8_WAIT_V(n) asm volatile("s_waitcnt vmcnt(" #n ")" ::: "memory")
#define PG8_WAIT_L(n) asm volatile("s_waitcnt lgkmcnt(" #n ")" ::: "memory")
#define PG8_BAR __builtin_amdgcn_s_barrier()
#define PG8_SCHED __builtin_amdgcn_sched_barrier(0)
    Unit cur, nxt; int ui = 0;
    if (!S.next(0, cur)) return;
    f32x4 acc[2][2][4][2];
#pragma unroll
    for (int a = 0; a < 2; ++a)
#pragma unroll
        for (int b = 0; b < 2; ++b)
#pragma unroll
            for (int m = 0; m < 4; ++m)
#pragma unroll
                for (int n = 0; n < 2; ++n) acc[a][b][m][n] = (f32x4){0.f, 0.f, 0.f, 0.f};
    bf16x8 At[4][2], B0[2][2], B1[2][2];
    const char* cA = (const char*)g.A + (size_t)cur.pm * tstep; const char* cB = (const char*)g.Bt + (size_t)cur.pn * tstep;
    S.a_ready(cur);
    if constexpr (SP2) {
        PG8_STAGE(PG8_SB(0, 0), cB, voffB); PG8_STAGE(PG8_SB(0, 1), cB + hstep, voffB); PG8_STAGE(PG8_SA(0, 0), cA, voffA); PG8_STAGE(PG8_SA(0, 1), cA + hstep, voffA);
        if (wr == 1) PG8_BAR;
        PG8_WAIT_V(2); PG8_BAR;
        PG8_STAGE(PG8_SB(1, 0), cB + kstep, voffB); PG8_STAGE(PG8_SA(1, 0), cA + kstep, voffA); PG8_STAGE(PG8_SB(1, 1), cB + hstep + kstep, voffB);
        PG8_WAIT_V(6); PG8_BAR;
    } else {
        PG8_STAGE(PG8_SB(0, 0), cB, voffB); PG8_STAGE(PG8_SA(0, 0), cA, voffA); PG8_STAGE(PG8_SB(0, 1), cB + hstep, voffB); PG8_STAGE(PG8_SA(0, 1), cA + hstep, voffA);
        if (wr == 1) PG8_BAR;
        PG8_WAIT_V(4); PG8_BAR;
        PG8_STAGE(PG8_SB(1, 0), cB + kstep, voffB); PG8_STAGE(PG8_SA(1, 0), cA + kstep, voffA); PG8_STAGE(PG8_SB(1, 1), cB + hstep + kstep, voffB);
        PG8_WAIT_V(6); PG8_BAR;
    }
    for (;;) {
        const bool has_next = S.next(ui + 1, nxt);
        const char* nA = has_next ? (const char*)g.A + (size_t)nxt.pm * tstep : cA; const char* nB = has_next ? (const char*)g.Bt + (size_t)nxt.pn * tstep : cB;
        for (int t = 0; t < nt; t += 2) {
            const bool last = (t == nt - 2);
            if constexpr (Epi::HAS_MID) { if (t == E.mid_t) E.mid(acc, cur, wr, wc, fr, fq); }
            const char* a1 = cA + (size_t)(t + 1) * kstep;
            const char* a2 = last ? nA : cA + (size_t)(t + 2) * kstep; const char* b2 = last ? nB : cB + (size_t)(t + 2) * kstep;
            const char* a3 = a2 + kstep; const char* b3 = b2 + kstep;
            if (last && has_next) S.a_ready(nxt);
            if constexpr (SP2) {
            PG8_LDB(B0, 0, 0); PG8_LDB(B1, 0, 1); PG8_SCHED; PG8_LDA(At, 0, 0); PG8_STAGE(PG8_SA(1, 1), a1 + hstep, voffA);
            PG8_WAIT_V(8); PG8_WAIT_L(0); PG8_BAR; PG8_MMA(0, 0, At, B0); PG8_MMA(0, 1, At, B1); PG8_BAR; PG8_SCHED;
            PG8_LDA(At, 0, 1); PG8_STAGE(PG8_SB(0, 0), b2, voffB); PG8_STAGE(PG8_SB(0, 1), b2 + hstep, voffB); PG8_STAGE(PG8_SA(0, 0), a2, voffA);
            PG8_WAIT_V(8); PG8_WAIT_L(0); PG8_BAR; PG8_MMA(1, 0, At, B0); PG8_MMA(1, 1, At, B1); PG8_BAR; PG8_SCHED;
            PG8_LDB(B0, 1, 0); PG8_LDB(B1, 1, 1); PG8_SCHED; PG8_LDA(At, 1, 0); PG8_STAGE(PG8_SA(0, 1), a2 + hstep, voffA);
            PG8_WAIT_V(8); PG8_WAIT_L(0); PG8_BAR; PG8_MMA(0, 0, At, B0); PG8_MMA(0, 1, At, B1); PG8_BAR; PG8_SCHED;
            PG8_LDA(At, 1, 1); PG8_STAGE(PG8_SB(1, 0), b3, voffB); PG8_STAGE(PG8_SB(1, 1), b3 + hstep, voffB); PG8_STAGE(PG8_SA(1, 0), a3, voffA);
            PG8_WAIT_V(8); PG8_WAIT_L(0); PG8_BAR; PG8_MMA(1, 0, At, B0); PG8_MMA(1, 1, At, B1); PG8_BAR; PG8_SCHED;
            } else {
            PG8_LDB(B0, 0, 0); PG8_SCHED; PG8_LDA(At, 0, 0); PG8_STAGE(PG8_SA(1, 1), a1 + hstep, voffA);
            PG8_WAIT_L(8); PG8_BAR; PG8_WAIT_L(0); PG8_MMA(0, 0, At, B0); PG8_BAR; PG8_SCHED;
            PG8_LDB(B1, 0, 1); PG8_STAGE(PG8_SB(0, 0), b2, voffB);
            PG8_BAR; PG8_WAIT_L(0); PG8_MMA(0, 1, At, B1); PG8_BAR;
            PG8_LDA(At, 0, 1); PG8_STAGE(PG8_SA(0, 0), a2, voffA);
            PG8_BAR; PG8_WAIT_L(0); PG8_MMA(1, 0, At, B0); PG8_BAR; PG8_SCHED;
            PG8_STAGE(PG8_SB(0, 1), b2 + hstep, voffB);
            PG8_WAIT_V(6); PG8_BAR; PG8_MMA(1, 1, At, B1); PG8_BAR;
            PG8_LDB(B0, 1, 0); PG8_SCHED; PG8_LDA(At, 1, 0); PG8_STAGE(PG8_SA(0, 1), a2 + hstep, voffA);
            PG8_WAIT_L(8); PG8_BAR; PG8_WAIT_L(0); PG8_MMA(0, 0, At, B0); PG8_BAR; PG8_SCHED;
            PG8_LDB(B1, 1, 1); PG8_STAGE(PG8_SB(1, 0), b3, voffB);
            PG8_BAR; PG8_WAIT_L(0); PG8_MMA(0, 1, At, B1); PG8_BAR;
            PG8_LDA(At, 1, 1); PG8_STAGE(PG8_SA(1, 0), a3, voffA);
            PG8_BAR; PG8_WAIT_L(0); PG8_MMA(1, 0, At, B0); PG8_BAR; PG8_SCHED;
            PG8_STAGE(PG8_SB(1, 1), b3 + hstep, voffB);
            PG8_WAIT_V(6); PG8_BAR; PG8_MMA(1, 1, At, B1); PG8_BAR;
            }
        }
        if constexpr (ALIGN_EPI) { if (wr == 0) PG8_BAR; }
        if constexpr (!Epi::AFTER_DRAIN) { E(acc, cur, wr, wc, fr, fq); S.done(cur); }
        if (!has_next) break;
#pragma unroll
        for (int a = 0; a < 2; ++a)
#pragma unroll
            for (int b = 0; b < 2; ++b)
#pragma unroll
                for (int m = 0; m < 4; ++m)
#pragma unroll
                    for (int n = 0; n < 2; ++n) acc[a][b][m][n] = (f32x4){0.f, 0.f, 0.f, 0.f};
        cur = nxt; cA = nA; cB = nB; ++ui;
        if constexpr (ALIGN_EPI) { if (wr == 1) PG8_BAR; }
    }
    PG8_WAIT_V(0);
    if constexpr (!ALIGN_EPI) { if (wr == 0) PG8_BAR; }
    PG8_BAR;
    if constexpr (Epi::AFTER_DRAIN) { E.fused(acc, cur, wr, wc, fr, fq, lds, wid, lane); S.done(cur); }
#undef PG8_SA
#undef PG8_SB
#undef PG8_STAGE
#undef PG8_LDA
#undef PG8_LDB
#undef PG8_MMA
#undef PG8_WAIT_V
#undef PG8_WAIT_L
#undef PG8_BAR
#undef PG8_SCHED
}
}
namespace att {
constexpr int   D = 128, NW = 8, QBLK = 32, KVBLK = 64;
constexpr float SCALE = 0.088388347648318440f;
constexpr float THR = 8.f;
constexpr int LDQ = 7168, LDK = 7168, LDO = 2048;
constexpr int SHM_V = KVBLK * D * 2, SHM_K = KVBLK * D * 2, SHM_ATTN = 2 * SHM_V + 2 * SHM_K + NW * 64 * 4;
typedef unsigned short bf16;
using bf16x8 = __attribute__((ext_vector_type(8))) short;
using s16x4  = __attribute__((ext_vector_type(4))) short;
using f32x16 = __attribute__((ext_vector_type(16))) float;
using u32x4  = __attribute__((ext_vector_type(4))) unsigned;
#define KSWZ(row, colB) ((row) * 256 + ((colB) ^ (((row) & 7) << 4)))
#define SBAR() __builtin_amdgcn_sched_barrier(0)
__device__ __forceinline__ int crow(int r, int hi) { return (r & 3) + 8 * (r >> 2) + 4 * hi; }
__device__ __forceinline__ unsigned cvtpk(float lo, float hi) { unsigned r; asm volatile("v_cvt_pk_bf16_f32 %0, %1, %2" : "=v"(r) : "v"(lo), "v"(hi)); return r; }

__device__ __forceinline__ void partialSM(f32x16& p0, f32x16& p1, float& m_reg, float& mn, float& alpha) {
  constexpr float C = SCALE * 1.4426950408889634f;
  float pmax = p0[0]; for (int r = 1; r < 16; ++r) pmax = fmaxf(pmax, p0[r]); for (int r = 0; r < 16; ++r) pmax = fmaxf(pmax, p1[r]);
  { auto rr = __builtin_amdgcn_permlane32_swap(__float_as_uint(pmax), __float_as_uint(pmax), false, false);
    pmax = fmaxf(__uint_as_float(rr[0]), __uint_as_float(rr[1])); }
  if (__builtin_expect(__all(pmax - m_reg <= THR / SCALE), 1)) { mn = m_reg; alpha = 1.f; }
  else { mn = fmaxf(m_reg, pmax); alpha = __builtin_amdgcn_exp2f((m_reg - mn) * C); m_reg = mn; }
  float mnC = -mn * C;
  for (int r = 0; r < 16; ++r) p0[r] = fmaf(p0[r], C, mnC); for (int r = 0; r < 16; ++r) p1[r] = fmaf(p1[r], C, mnC);
  for (int r = 0; r < 16; ++r) p0[r] = __builtin_amdgcn_exp2f(p0[r]);
}
__device__ __forceinline__ void finishSM(f32x16& p0, f32x16& p1, float alpha, float& l_reg, bf16x8& pa0, bf16x8& pa1, bf16x8& pa2, bf16x8& pa3) {
  for (int r = 0; r < 16; ++r) p1[r] = __builtin_amdgcn_exp2f(p1[r]);
  float ps = 0; for (int r = 0; r < 16; ++r) ps += p0[r]; for (int r = 0; r < 16; ++r) ps += p1[r];
  { auto rr = __builtin_amdgcn_permlane32_swap(__float_as_uint(ps), __float_as_uint(ps), false, false);
    ps = __uint_as_float(rr[0]) + __uint_as_float(rr[1]); }
  l_reg = l_reg * alpha + ps;
#define PK4(P, BASE, OUT) do { unsigned a0 = cvtpk(P[BASE + 0], P[BASE + 1]), a1 = cvtpk(P[BASE + 2], P[BASE + 3]);   \
    unsigned b0 = cvtpk(P[BASE + 4], P[BASE + 5]), b1 = cvtpk(P[BASE + 6], P[BASE + 7]);                              \
    auto r0 = __builtin_amdgcn_permlane32_swap(a0, b0, false, false); auto r1 = __builtin_amdgcn_permlane32_swap(a1, b1, false, false); \
    u32x4 w = {r0[0], r1[0], r0[1], r1[1]}; OUT = *reinterpret_cast<bf16x8*>(&w); } while (0)
  PK4(p0, 0, pa0); PK4(p0, 8, pa1); PK4(p1, 0, pa2); PK4(p1, 8, pa3);
#undef PK4
}
__device__ __forceinline__ void qkt(f32x16& p0, f32x16& p1, const bf16* Ks, const bf16x8* qr, int r32, int hi) {
  p0 = f32x16{}; p1 = f32x16{};
  for (int d0 = 0; d0 < 8; ++d0) { int cb = (d0 * 16 + hi * 8) * 2;
    bf16x8 b0 = *reinterpret_cast<const bf16x8*>((const char*)Ks + KSWZ(r32, cb));
    bf16x8 b1 = *reinterpret_cast<const bf16x8*>((const char*)Ks + KSWZ(32 + r32, cb));
    p0 = __builtin_amdgcn_mfma_f32_32x32x16_bf16(b0, qr[d0], p0, 0, 0, 0);
    p1 = __builtin_amdgcn_mfma_f32_32x32x16_bf16(b1, qr[d0], p1, 0, 0, 0); }
}
__device__ __forceinline__ void wmask(f32x16& p0, f32x16& p1, int dk0, int hi) {
#pragma unroll
  for (int r = 0; r < 16; ++r) { const int d = dk0 + crow(r, hi); p0[r] = (d >= -128 && d <= 128) ? p0[r] : -1e30f; const int e = d + 32; p1[r] = (e >= -128 && e <= 128) ? p1[r] : -1e30f; }
}
__device__ __forceinline__ int v_st(int k, int c) { const int kk = (k & ~0xC) | ((k & 4) << 1) | ((k & 8) >> 1); return ((kk >> 3) * 4 + (c >> 5)) * 512 + ((kk & 7) * 32 + (c & 31)) * 2; }
__device__ __forceinline__ int v_rd_base(int lane) { return ((lane & 3) << 3) | (((lane >> 2) & 3) << 6) | (((lane >> 4) & 1) << 5) | (((lane >> 5) & 1) << 8); }
constexpr int v_rd_off(int d0, int ks, int half) { return d0 * 512 + ks * 4096 + half * 2048; }
template <int OFF> __device__ __forceinline__ s16x4 tr_read(int vb) {
  s16x4 r; asm volatile("ds_read_b64_tr_b16 %0, %1 offset:%2" : "=&v"(r) : "v"(vb), "i"(OFF) : "memory"); return r;
}
template <int D0> __device__ __forceinline__ void pv_one(f32x16& od, int vb, bf16x8 pa0, bf16x8 pa1, bf16x8 pa2, bf16x8 pa3) {
  const s16x4 l0 = tr_read<v_rd_off(D0, 0, 0)>(vb), h0 = tr_read<v_rd_off(D0, 0, 1)>(vb), l1 = tr_read<v_rd_off(D0, 1, 0)>(vb), h1 = tr_read<v_rd_off(D0, 1, 1)>(vb);
  const s16x4 l2 = tr_read<v_rd_off(D0, 2, 0)>(vb), h2 = tr_read<v_rd_off(D0, 2, 1)>(vb), l3 = tr_read<v_rd_off(D0, 3, 0)>(vb), h3 = tr_read<v_rd_off(D0, 3, 1)>(vb);
  asm volatile("s_waitcnt lgkmcnt(0)" ::: "memory"); SBAR();
#define PK(L, H) (bf16x8){L[0], L[1], L[2], L[3], H[0], H[1], H[2], H[3]}
  od = __builtin_amdgcn_mfma_f32_32x32x16_bf16(pa0, PK(l0, h0), od, 0, 0, 0);
  od = __builtin_amdgcn_mfma_f32_32x32x16_bf16(pa1, PK(l1, h1), od, 0, 0, 0);
  od = __builtin_amdgcn_mfma_f32_32x32x16_bf16(pa2, PK(l2, h2), od, 0, 0, 0);
  od = __builtin_amdgcn_mfma_f32_32x32x16_bf16(pa3, PK(l3, h3), od, 0, 0, 0);
#undef PK
}
__device__ __forceinline__ void pv_d0(f32x16* o, int vb, bf16x8 pa0, bf16x8 pa1, bf16x8 pa2, bf16x8 pa3) {
  pv_one<0>(o[0], vb, pa0, pa1, pa2, pa3); pv_one<1>(o[1], vb, pa0, pa1, pa2, pa3); pv_one<2>(o[2], vb, pa0, pa1, pa2, pa3); pv_one<3>(o[3], vb, pa0, pa1, pa2, pa3);
}

template <bool WIN, int SDEPTH = 2>
__device__ __forceinline__ void attn_body(const bf16* __restrict__ Qb, const bf16* __restrict__ Kh, const bf16* __restrict__ Vh,
                                          bf16* __restrict__ Ob, int ntiles, int dq0, float sink, char* lds) {
  int tid = threadIdx.x; asm volatile("" : "+v"(tid));
  const int wid = __builtin_amdgcn_readfirstlane(tid >> 6), lane = tid & 63, r32 = lane & 31, hi = lane >> 5;
  bf16* V_lds = (bf16*)lds; bf16* K_lds = (bf16*)(lds + 2 * SHM_V);
  float* ws = (float*)(lds + 2 * SHM_V + 2 * SHM_K) + wid * 64; float* li_l = ws; float* al_l = ws + 32;
  float m_reg = WIN ? sink * (1.0f / SCALE) : -1e30f, l_reg = WIN ? 1.f : 0.f; f32x16 o[4] = {}; bf16x8 qr[8];
  const bf16* Qw = Qb + (long)(wid * QBLK + r32) * LDQ + hi * 8;
#pragma unroll
  for (int d0 = 0; d0 < 8; ++d0) qr[d0] = *reinterpret_cast<const bf16x8*>(Qw + d0 * 16);
  const int sr = tid >> 4, sc = (tid & 15) * 8, vst0 = v_st(sr, sc), vst1 = v_st(32 + sr, sc);
  const int vb0 = (int)(uintptr_t)V_lds + v_rd_base(lane);
  const int dkl = dq0 - (wid * QBLK + r32);
  struct { bf16x8 vs0, vs1, ks0, ks1; } sr_[SDEPTH];
#define SLOAD(i, k0) do { sr_[i].vs0 = *reinterpret_cast<const bf16x8*>(&Vh[(long)((k0) + sr) * LDK + sc]); sr_[i].vs1 = *reinterpret_cast<const bf16x8*>(&Vh[(long)((k0) + 32 + sr) * LDK + sc]); \
    sr_[i].ks0 = *reinterpret_cast<const bf16x8*>(&Kh[(long)((k0) + sr) * LDK + sc]); sr_[i].ks1 = *reinterpret_cast<const bf16x8*>(&Kh[(long)((k0) + 32 + sr) * LDK + sc]); } while (0)
#define SWRITE(b, i) do { *(bf16x8*)((char*)V_lds + (b) * SHM_V + vst0) = sr_[i].vs0;          \
    *(bf16x8*)((char*)V_lds + (b) * SHM_V + vst1) = sr_[i].vs1; int kc = sc * 2;               \
    *(bf16x8*)((char*)K_lds + (b) * SHM_K + KSWZ(sr, kc)) = sr_[i].ks0;                       \
    *(bf16x8*)((char*)K_lds + (b) * SHM_K + KSWZ(32 + sr, kc)) = sr_[i].ks1; } while (0)
#define SWAIT() do { if constexpr (SDEPTH == 2) asm volatile("s_waitcnt vmcnt(4)" ::: "memory"); else asm volatile("s_waitcnt vmcnt(0)" ::: "memory"); } while (0)
#define RESC(a) do { if (__any((a) < 1.f)) { if (hi == 0) al_l[r32] = (a); asm volatile("s_waitcnt lgkmcnt(0)" ::: "memory"); \
    for (int d = 0; d < 4; ++d) for (int r = 0; r < 16; ++r) o[d][r] *= al_l[crow(r, hi)]; } } while (0)
#define WMASK(P0, P1, j) do { if (WIN) { const int dw = dq0 + (j) * KVBLK - wid * QBLK; if (!(dw + 63 <= 128 && dw - 31 >= -128)) wmask(P0, P1, dkl + (j) * KVBLK, hi); } } while (0)
  f32x16 pA0, pA1, pB0, pB1; float mnA, mnB, alA, alB; bf16x8 pa0, pa1, pa2, pa3; const int NT = ntiles;
  constexpr int SE = 0, SO = SDEPTH - 1;
  SLOAD(SE, 0); asm volatile("s_waitcnt vmcnt(0)" ::: "memory"); SWRITE(0, SE); __syncthreads();
  qkt(pA0, pA1, K_lds, qr, r32, hi); WMASK(pA0, pA1, 0); partialSM(pA0, pA1, m_reg, mnA, alA);
  SLOAD(SO, KVBLK); if constexpr (SDEPTH == 2) { if (2 < NT) SLOAD(SE, 2 * KVBLK); }
  SWAIT(); SWRITE(1, SO); __syncthreads();
  for (int j = 1; j + 1 < NT; j += 2) {
    SBAR(); qkt(pB0, pB1, (bf16*)((char*)K_lds + SHM_K), qr, r32, hi); WMASK(pB0, pB1, j);
    finishSM(pA0, pA1, alA, l_reg, pa0, pa1, pa2, pa3); SBAR();
    SLOAD(SO, (j + SDEPTH) * KVBLK); SBAR();
    pv_d0(o, vb0, pa0, pa1, pa2, pa3); partialSM(pB0, pB1, m_reg, mnB, alB);
    __syncthreads(); SWAIT(); SWRITE(0, SE);
    RESC(alB); __syncthreads();
    SBAR(); qkt(pA0, pA1, K_lds, qr, r32, hi); WMASK(pA0, pA1, j + 1);
    finishSM(pB0, pB1, alB, l_reg, pa0, pa1, pa2, pa3); SBAR();
    if (SDEPTH == 1 || j + 3 < NT) SLOAD(SE, (j + 1 + SDEPTH) * KVBLK); SBAR();
    pv_d0(o, vb0 + (int)SHM_V, pa0, pa1, pa2, pa3); partialSM(pA0, pA1, m_reg, mnA, alA);
    __syncthreads(); SWAIT(); SWRITE(1, SO);
    RESC(alA); __syncthreads();
  }
  SBAR(); qkt(pB0, pB1, (bf16*)((char*)K_lds + SHM_K), qr, r32, hi); WMASK(pB0, pB1, NT - 1);
  finishSM(pA0, pA1, alA, l_reg, pa0, pa1, pa2, pa3); SBAR();
  pv_d0(o, vb0, pa0, pa1, pa2, pa3); partialSM(pB0, pB1, m_reg, mnB, alB);
  __syncthreads(); RESC(alB);
  finishSM(pB0, pB1, alB, l_reg, pa0, pa1, pa2, pa3); SBAR();
  pv_d0(o, vb0 + (int)SHM_V, pa0, pa1, pa2, pa3);
  if (hi == 0) li_l[r32] = l_reg; asm volatile("s_waitcnt lgkmcnt(0)" ::: "memory");
  float rli[16];
#pragma unroll
  for (int r = 0; r < 16; ++r) rli[r] = __builtin_amdgcn_rcpf(li_l[crow(r, hi)]);
  __syncthreads();
  unsigned short* stg = (unsigned short*)(lds + wid * 8192);
#pragma unroll
  for (int r = 0; r < 16; ++r) { const int orow = crow(r, hi);
#pragma unroll
    for (int d0 = 0; d0 < 4; ++d0) { const unsigned w = cvtpk(o[d0][r] * rli[r], 0.f); stg[orow * 128 + d0 * 32 + r32] = (unsigned short)w; } }
  asm volatile("s_waitcnt lgkmcnt(0)" ::: "memory");
  bf16* Ow = Ob + (long)(wid * QBLK) * LDO;
#pragma unroll
  for (int i = 0; i < 8; ++i) { const int idx = i * 64 + lane, row = idx >> 4, c8 = (idx & 15) * 8;
    const u32x4 v = *reinterpret_cast<const u32x4*>(stg + row * 128 + c8);
    *reinterpret_cast<u32x4*>(Ow + (long)row * LDO + c8) = v; }
  __syncthreads();
#undef SLOAD
#undef SWRITE
#undef SWAIT
#undef RESC
#undef WMASK
}
#undef KSWZ
#undef SBAR
}
#ifndef MK_LAUNCH_MODE
#define MK_LAUNCH_MODE 1
#endif
constexpr int NWAVES = 8;
constexpr int DM = 2048, NTOK = 40960, S0 = 8192, S1 = 4096, NBATCH = 9, DEPTH = 4, INW = 7168, DFF = 5632, NMOD = 6 * DM;
constexpr int Z_QA = 0, Z_KA = 1024, Z_VA = 1280, Z_QB = 1536, Z_KB = 2560, Z_VB = 2816, Z_GA = 3072, Z_GB = 5120;
constexpr float EPS = 1e-6f;
constexpr size_t MiB = 1u << 20;
constexpr size_t WS_CTL = 0, CTL_ZERO_BYTES = 1 * MiB;
constexpr size_t WS_MOD = 1 * MiB;
constexpr size_t WS_TAB = 3 * MiB;
constexpr size_t TAB_COS1 = 0, TAB_SIN1 = 8192 * 64, TAB_CR = 2 * 8192 * 64, TAB_SR = TAB_CR + 128 * 32, TAB_CC = TAB_SR + 128 * 32, TAB_SC = TAB_CC + 64 * 32;
constexpr size_t WS_WT = 8 * MiB;
constexpr size_t W_IN = 0, W_BR = W_IN + (size_t)INW * DM, W_OUT = W_BR + (size_t)DM * DM, W_13 = W_OUT + (size_t)DM * DM, W_2 = W_13 + (size_t)2 * DFF * DM, LAYER_W = W_2 + (size_t)DM * DFF;
constexpr size_t WS_U = WS_WT + DEPTH * LAYER_W * 2;
constexpr size_t WS_Z = WS_U + (size_t)NTOK * DM * 2;
constexpr size_t WS_O = WS_Z + (size_t)NTOK * INW * 2;
constexpr size_t WS_MG = WS_O + (size_t)NTOK * DM * 2;
constexpr size_t WS_END = WS_MG + (size_t)NTOK * DM * 2;
static_assert(WS_WT % 256 == 0 && WS_U % 256 == 0 && WS_Z % 256 == 0 && WS_O % 256 == 0 && WS_MG % 256 == 0, "ws map alignment");
static_assert((size_t)NTOK * DFF * 2 <= (size_t)NTOK * INW * 2, "H overlays Z");
constexpr int CW_TMO = 0, CW_CODE = 1, CW_BAR = 4096;
constexpr int RING_OFF = 0, RING_BYTES = 131072, LDSCTL_OFF = RING_BYTES, MISC_OFF = LDSCTL_OFF + 320, LDS_BYTES = 147456;
constexpr int PH_PRO = 0, PH_NORM0 = 1, PH_L0 = 2, PH_PER_LAYER = 9, N_PHASES = PH_L0 + DEPTH * PH_PER_LAYER;

#define GAS __attribute__((address_space(1)))
#define LAS __attribute__((address_space(3)))
typedef unsigned short bf16;
typedef unsigned v4u __attribute__((ext_vector_type(4)));
typedef unsigned v2u __attribute__((ext_vector_type(2)));
typedef float f32x4 __attribute__((ext_vector_type(4)));
typedef GAS unsigned gu32;
#define RLX_AGENT __ATOMIC_RELAXED, __HIP_MEMORY_SCOPE_AGENT
#define LDS_WAIT() asm volatile("s_waitcnt lgkmcnt(0)" ::: "memory")
#define VM_WAIT() asm volatile("s_waitcnt vmcnt(0)" ::: "memory")
__device__ __forceinline__ unsigned f2bf(float f) { unsigned u = __builtin_bit_cast(unsigned, f); return (u + 0x7fffu + ((u >> 16) & 1u)) >> 16; }
__device__ __forceinline__ unsigned pk2(float lo, float hi) { return f2bf(lo) | (f2bf(hi) << 16); }
__device__ __forceinline__ float bflo(unsigned w) { return __uint_as_float(w << 16); }
__device__ __forceinline__ float bfhi(unsigned w) { return __uint_as_float(w & 0xffff0000u); }

#define XB_TMO      128
#define XB_XCNT(j)  (256  + 64 * (j))
#define XB_XSUB(j)  (1280 + 64 * (j))
#define XB_XGEN(j)  (2304 + 64 * (j))
#define XB_TOP      3328
#define XB_TOPGEN   3392
#define XCD_BAR_WORDS 3456
#define XB_SPIN_CAP (1u << 18)

__device__ __forceinline__ unsigned xb_ld(unsigned* p)              { return __hip_atomic_load(p, __ATOMIC_RELAXED, __HIP_MEMORY_SCOPE_AGENT); }
__device__ __forceinline__ unsigned xb_add(unsigned* p, unsigned v) { return __hip_atomic_fetch_add(p, v, __ATOMIC_RELAXED, __HIP_MEMORY_SCOPE_AGENT); }
__device__ __forceinline__ unsigned xb_xcc_id() { return (unsigned)__builtin_amdgcn_s_getreg((3 << 11) | 20) & 0xFu; }
#define XB_SPIN(cond, bar) do { unsigned _sp = 0; while (cond) { __builtin_amdgcn_s_sleep(1); \
    if ((++_sp & 255u) == 0u) { if (xb_ld(&(bar)[XB_TMO])) break; if (_sp > XB_SPIN_CAP) { atomicAdd(&(bar)[XB_TMO], 1u); break; } } } } while (0)

struct XcdBarrier {
    unsigned* bar; unsigned x;
    volatile LAS unsigned* st;
};

__device__ __forceinline__ XcdBarrier xcd_barrier_post(unsigned* bar, volatile LAS unsigned* st) {
    XcdBarrier b; b.bar = bar; b.x = xb_xcc_id(); b.st = st;
    if (threadIdx.x == 0) (void)xb_add(&bar[XB_XCNT(b.x)], 1u);
    return b;
}
__device__ __forceinline__ void xcd_barrier_complete(unsigned* bar, unsigned x, unsigned& nloc, unsigned& nx) {
    const unsigned G = gridDim.x * gridDim.y * gridDim.z;
    unsigned sum, cnt, mine, sp = 0u;
    for (;;) {
        sum = 0u; cnt = 0u; mine = 0u;
#pragma unroll
        for (unsigned j = 0; j < 16; ++j) { const unsigned c = xb_ld(&bar[XB_XCNT(j)]); sum += c; cnt += (c > 0u) ? 1u : 0u; mine = (j == x) ? c : mine; }
        if (sum == G) break;
        __builtin_amdgcn_s_sleep(1);
        if ((++sp & 255u) == 0u) { if (xb_ld(&bar[XB_TMO])) break; if (sp > XB_SPIN_CAP) { atomicAdd(&bar[XB_TMO], 1u); break; } }
    }
    nloc = mine > 0u ? mine : 1u; nx = cnt > 0u ? cnt : 1u;
}

__device__ __forceinline__ void xcd_barrier(const XcdBarrier& b) {
    asm volatile("s_waitcnt vmcnt(0)" ::: "memory");
    __syncthreads();
    if (threadIdx.x == 0) {
        unsigned* bar = b.bar;
        __builtin_amdgcn_s_waitcnt(0);
        unsigned nloc = b.st[0], nx = b.st[1];
        if (nloc == 0u) { xcd_barrier_complete(bar, b.x, nloc, nx); b.st[0] = nloc; b.st[1] = nx; }
        const unsigned old = xb_add(&bar[XB_XSUB(b.x)], 1u);
        const unsigned gen = old / nloc;
        if (old + 1u == (gen + 1u) * nloc) {
            __builtin_amdgcn_fence(__ATOMIC_RELEASE, "agent");
            asm volatile("s_waitcnt vmcnt(0)" ::: "memory");
            const unsigned og = xb_add(&bar[XB_TOP], 1u);
            const unsigned tg = og / nx;
            if (og + 1u == (tg + 1u) * nx) xb_add(&bar[XB_TOPGEN], 1u);
            else XB_SPIN(xb_ld(&bar[XB_TOPGEN]) == tg, bar);
            __builtin_amdgcn_fence(__ATOMIC_ACQUIRE, "agent");
            xb_add(&bar[XB_XGEN(b.x)], 1u);
            asm volatile("s_waitcnt vmcnt(0)" ::: "memory");
        } else {
            XB_SPIN(xb_ld(&bar[XB_XGEN(b.x)]) == gen, bar);
            __builtin_amdgcn_fence(__ATOMIC_ACQUIRE, "agent");
            asm volatile("s_waitcnt vmcnt(0)" ::: "memory");
        }
    }
    __syncthreads();
}


struct Args { const float* in[19]; float* out; unsigned char* ws; int ph_lo, ph_hi, li, pad; };

__device__ __forceinline__ float wave_sum(float v) {
#pragma unroll
    for (int o = 1; o < 64; o <<= 1) v += __shfl_xor(v, o);
    return v;
}
__device__ __forceinline__ int row_batch(int row) { return row < S0 ? 0 : 1 + ((row - S0) >> 12); }
__device__ __forceinline__ int row_pos(int row) { return row < S0 ? row : ((row - S0) & (S1 - 1)); }

__device__ __forceinline__ void sincos_d(double a, float& s, float& c) {
    const double q = __builtin_rint(a * 0.63661977236758134308);
    double r = __builtin_fma(-q, 1.5707963267948966, a); r = __builtin_fma(-q, 6.123233995736766e-17, r);
    const double r2 = r * r;
    double sp = 1.0 / 6227020800.0; sp = sp * r2 - 1.0 / 39916800.0; sp = sp * r2 + 1.0 / 362880.0; sp = sp * r2 - 1.0 / 5040.0; sp = sp * r2 + 1.0 / 120.0; sp = sp * r2 - 1.0 / 6.0; sp = sp * r2 + 1.0; sp = sp * r;
    double cp = -1.0 / 87178291200.0; cp = cp * r2 + 1.0 / 479001600.0; cp = cp * r2 - 1.0 / 3628800.0; cp = cp * r2 + 1.0 / 40320.0; cp = cp * r2 - 1.0 / 720.0; cp = cp * r2 + 1.0 / 24.0; cp = cp * r2 - 0.5; cp = cp * r2 + 1.0;
    const int qi = (int)((long long)q & 3);
    const double ss = (qi & 1) ? cp : sp, cc = (qi & 1) ? sp : cp;
    s = (float)((qi & 2) ? -ss : ss); c = (float)(((qi + 1) & 2) ? -cc : cc);
}
__device__ __forceinline__ float inv_freq(int i, double base) { double v = 1.0; for (int k = 0; k < i; ++k) v *= base; return (float)v; }
__device__ __forceinline__ void p0_tables(float* tab, int gt, int ngt) {
    for (int idx = gt; idx < 8192 * 64; idx += ngt) { const int pos = idx >> 6, i = idx & 63; const float f = inv_freq(i, 0.8659643233600653); const float ang = (float)pos * f;
        float s, c; sincos_d((double)ang, s, c); tab[TAB_COS1 + idx] = c; tab[TAB_SIN1 + idx] = s; }
    for (int idx = gt; idx < 128 * 32; idx += ngt) { const int pos = idx >> 5, i = idx & 31; const float f = inv_freq(i, 0.7498942093324558); const float ang = (float)pos * f;
        float s, c; sincos_d((double)ang, s, c); tab[TAB_CR + idx] = c; tab[TAB_SR + idx] = s; if (pos < 64) { tab[TAB_CC + idx] = c; tab[TAB_SC + idx] = s; } }
}
__device__ __forceinline__ void p0_mod_item(const float* cp, const float* cs, const float* wmod, const float* bmod, float* mod, LAS float* sc, int item, int tid, int wave, int lane) {
    const int l = item / (NMOD / 256), col0 = (item % (NMOD / 256)) * 256;
    for (int i = tid; i < NBATCH * DM; i += 512) { const float v = (i < DM) ? cp[i] : cs[i - DM]; sc[i] = v * __builtin_amdgcn_rcpf(1.0f + __expf(-v)); }
    __syncthreads();
    f32x4 acc[NBATCH];
#pragma unroll
    for (int b = 0; b < NBATCH; ++b) acc[b] = (f32x4){0.f, 0.f, 0.f, 0.f};
    const float* wp = wmod + (size_t)l * DM * NMOD + (size_t)(wave * 256) * NMOD + col0 + lane * 4;
    for (int k4 = 0; k4 < 64; ++k4) {
        f32x4 w[4];
#pragma unroll
        for (int kk = 0; kk < 4; ++kk) w[kk] = *(const f32x4*)(wp + (size_t)(k4 * 4 + kk) * NMOD);
#pragma unroll
        for (int b = 0; b < NBATCH; ++b) { const f32x4 s4 = *(const LAS f32x4*)(sc + b * DM + wave * 256 + k4 * 4);
            acc[b] += w[0] * s4[0]; acc[b] += w[1] * s4[1]; acc[b] += w[2] * s4[2]; acc[b] += w[3] * s4[3]; }
    }
    __syncthreads();
#pragma unroll
    for (int b = 0; b < NBATCH; ++b) *(LAS f32x4*)(sc + (wave * NBATCH + b) * 256 + lane * 4) = acc[b];
    __syncthreads();
    for (int i = tid; i < NBATCH * 256; i += 512) { const int b = i >> 8, c = i & 255; float s = bmod[(size_t)l * NMOD + col0 + c];
#pragma unroll
        for (int w = 0; w < NWAVES; ++w) s += sc[(w * NBATCH + b) * 256 + c];
        mod[((size_t)l * NBATCH + b) * NMOD + col0 + c] = s; }
    __syncthreads();
}
__device__ __forceinline__ void p0_transpose_item(const float* W, int N, int k0, int n0, bf16* WT, int ldk, int drow0, int kdst0, LAS float* scr, int lane) {
#pragma unroll 8
    for (int i = 0; i < 32; ++i) { const int kk = 2 * i + (lane >> 5); scr[kk * 33 + (lane & 31)] = W[(size_t)(k0 + kk) * N + n0 + (lane & 31)]; }
    LDS_WAIT(); asm volatile("" ::: "memory");
    const int c = lane & 7;
#pragma unroll
    for (int j = 0; j < 4; ++j) { const int n = (lane >> 3) + 8 * j; const LAS float* s = scr + (8 * c) * 33 + n;
        v4u o; o.x = pk2(s[0 * 33], s[1 * 33]); o.y = pk2(s[2 * 33], s[3 * 33]); o.z = pk2(s[4 * 33], s[5 * 33]); o.w = pk2(s[6 * 33], s[7 * 33]);
        *(GAS v4u*)(WT + (size_t)(drow0 + n) * ldk + kdst0 + 8 * c) = o; }
    LDS_WAIT(); asm volatile("" ::: "memory");
}
constexpr int I_IN = (DM / 64) * (INW / 32), I_BR = (1024 / 64) * (DM / 32), I_OUT = (DM / 64) * (DM / 32), I_13 = (DM / 64) * (2 * DFF / 32), I_2 = (DFF / 64) * (DM / 32);
constexpr int I_LAYER = I_IN + 2 * I_BR + I_OUT + I_13 + I_2;
template <class AP> __device__ __forceinline__ void p0_transposes(AP a, bf16* wt, LAS float* scr, int gw, int ngw, int lane) {
    for (int it = gw; it < DEPTH * I_LAYER; it += ngw) {
        const int l = it / I_LAYER; int r = it % I_LAYER; bf16* wl = wt + (size_t)l * LAYER_W;
        if (r < I_IN) { const int nb = r % (INW / 32), kb = r / (INW / 32); p0_transpose_item(a->in[10] + (size_t)l * DM * INW, INW, 64 * kb, 32 * nb, wl + W_IN, DM, 32 * nb, 64 * kb, scr, lane); continue; } r -= I_IN;
        if (r < I_BR) { const int nb = r % (DM / 32), kb = r / (DM / 32); p0_transpose_item(a->in[14] + (size_t)l * 1024 * DM, DM, 64 * kb, 32 * nb, wl + W_BR, DM, 32 * nb, 64 * kb, scr, lane); continue; } r -= I_BR;
        if (r < I_BR) { const int nb = r % (DM / 32), kb = r / (DM / 32); p0_transpose_item(a->in[15] + (size_t)l * 1024 * DM, DM, 64 * kb, 32 * nb, wl + W_BR, DM, 32 * nb, 1024 + 64 * kb, scr, lane); continue; } r -= I_BR;
        if (r < I_OUT) { const int nb = r % (DM / 32), kb = r / (DM / 32); p0_transpose_item(a->in[16] + (size_t)l * DM * DM, DM, 64 * kb, 32 * nb, wl + W_OUT, DM, 32 * nb, 64 * kb, scr, lane); continue; } r -= I_OUT;
        if (r < I_13) { const int nb = r % (2 * DFF / 32), kb = r / (2 * DFF / 32); const int n0 = 32 * nb; const int j = n0 < DFF ? n0 : n0 - DFF; const int drow = 256 * (j >> 7) + (n0 < DFF ? 0 : 128) + (j & 127);
            p0_transpose_item(a->in[17] + (size_t)l * DM * 2 * DFF, 2 * DFF, 64 * kb, n0, wl + W_13, DM, drow, 64 * kb, scr, lane); continue; } r -= I_13;
        { const int nb = r % (DM / 32), kb = r / (DM / 32); p0_transpose_item(a->in[18] + (size_t)l * DFF * DM, DM, 64 * kb, 32 * nb, wl + W_2, DFF, 32 * nb, 64 * kb, scr, lane); }
    }
}

template <int MODE, bool DO_U>
__device__ __forceinline__ void norm_phase(const float* xin, const float* xin2, float* xout, const bf16* y, bf16* u, const float* g_post, const float* gate, const float* g_pre, const float* scale, const float* shift,
                                           int gw, int ngw, int lane) {
    const int rpw = (NTOK + ngw - 1) / ngw, r0 = gw * rpw, r1 = (r0 + rpw < NTOK) ? r0 + rpw : NTOK;
    f32x4 A[8], Bv[8], Cv[8]; int curb = -1;
    for (int row = r0; row < r1; ++row) {
        const int b = row_batch(row);
        if (b != curb) { curb = b;
#pragma unroll
            for (int j = 0; j < 8; ++j) { const int c = 256 * j + 4 * lane;
                if (MODE == 1) A[j] = *(const f32x4*)(gate + (size_t)b * NMOD + c) * *(const f32x4*)(g_post + c);
                if (DO_U) { Bv[j] = *(const f32x4*)(g_pre + c) * (*(const f32x4*)(scale + (size_t)b * NMOD + c) + 1.0f); Cv[j] = *(const f32x4*)(shift + (size_t)b * NMOD + c); } } }
        f32x4 x[8];
        const float* xr = (MODE == 0 ? (row < S0 ? xin + (size_t)row * DM : xin2 + (size_t)(row - S0) * DM) : xout + (size_t)row * DM) + 4 * lane;
#pragma unroll
        for (int j = 0; j < 8; ++j) x[j] = *(const f32x4*)(xr + 256 * j);
        if (MODE == 1) {
            f32x4 yv[8]; const bf16* yr = y + (size_t)row * DM + 4 * lane; float ss = 0.f;
#pragma unroll
            for (int j = 0; j < 8; ++j) { const v2u w = *(const v2u*)(yr + 256 * j); yv[j] = (f32x4){bflo(w.x), bfhi(w.x), bflo(w.y), bfhi(w.y)}; ss += (yv[j][0] * yv[j][0] + yv[j][1] * yv[j][1]) + (yv[j][2] * yv[j][2] + yv[j][3] * yv[j][3]); }
            const float rstd = __builtin_amdgcn_rsqf(wave_sum(ss) * (1.0f / DM) + EPS);
#pragma unroll
            for (int j = 0; j < 8; ++j) x[j] += A[j] * (yv[j] * rstd);
        }
        float* xo = xout + (size_t)row * DM + 4 * lane;
#pragma unroll
        for (int j = 0; j < 8; ++j) *(f32x4*)(xo + 256 * j) = x[j];
        if (DO_U) {
            float ss = 0.f;
#pragma unroll
            for (int j = 0; j < 8; ++j) ss += (x[j][0] * x[j][0] + x[j][1] * x[j][1]) + (x[j][2] * x[j][2] + x[j][3] * x[j][3]);
            const float rstd = __builtin_amdgcn_rsqf(wave_sum(ss) * (1.0f / DM) + EPS);
            bf16* ur = u + (size_t)row * DM + 4 * lane;
#pragma unroll
            for (int j = 0; j < 8; ++j) { const f32x4 v = x[j] * rstd * Bv[j] + Cv[j]; v2u w; w.x = pk2(v[0], v[1]); w.y = pk2(v[2], v[3]); *(v2u*)(ur + 256 * j) = w; }
        }
    }
}

__device__ __forceinline__ void prep_phase(bf16* z, const float* tab, const float* qn, const float* kn, int gw, int ngw, int lane) {
    const int sub = lane >> 3, j = lane & 7;
    for (int item = gw; item < NTOK * 20 / 8; item += ngw) {
        const int s = item * 8 + sub, row = s / 20, hs = s - row * 20, pos = row_pos(row);
        const bool axial = hs >= 10; const bool isq = (hs < 8) || (hs >= 10 && hs < 18);
        const int col = hs < 8 ? Z_QA + hs * 128 : hs < 10 ? Z_KA + (hs - 8) * 128 : hs < 18 ? Z_QB + (hs - 10) * 128 : Z_KB + (hs - 18) * 128;
        int e1, e2; const float *ct, *st;
        if (!axial) { e1 = 8 * j; e2 = 64 + 8 * j; ct = tab + TAB_COS1 + (size_t)pos * 64 + 8 * j; st = tab + TAB_SIN1 + (size_t)pos * 64 + 8 * j; }
        else if (j < 4) { e1 = 8 * j; e2 = 32 + 8 * j; ct = tab + TAB_CR + (pos >> 6) * 32 + 8 * j; st = tab + TAB_SR + (pos >> 6) * 32 + 8 * j; }
        else { e1 = 64 + 8 * (j - 4); e2 = 96 + 8 * (j - 4); ct = tab + TAB_CC + (pos & 63) * 32 + 8 * (j - 4); st = tab + TAB_SC + (pos & 63) * 32 + 8 * (j - 4); }
        bf16* zp = z + (size_t)row * INW + col;
        const v4u w1 = *(const v4u*)(zp + e1), w2 = *(const v4u*)(zp + e2);
        float x1[8], x2[8];
        x1[0] = bflo(w1.x); x1[1] = bfhi(w1.x); x1[2] = bflo(w1.y); x1[3] = bfhi(w1.y); x1[4] = bflo(w1.z); x1[5] = bfhi(w1.z); x1[6] = bflo(w1.w); x1[7] = bfhi(w1.w);
        x2[0] = bflo(w2.x); x2[1] = bfhi(w2.x); x2[2] = bflo(w2.y); x2[3] = bfhi(w2.y); x2[4] = bflo(w2.z); x2[5] = bfhi(w2.z); x2[6] = bflo(w2.w); x2[7] = bfhi(w2.w);
        if (axial) {
            float ss = 0.f;
#pragma unroll
            for (int i = 0; i < 8; ++i) ss += x1[i] * x1[i] + x2[i] * x2[i];
            ss += __shfl_xor(ss, 1); ss += __shfl_xor(ss, 2); ss += __shfl_xor(ss, 4);
            const float rstd = __builtin_amdgcn_rsqf(ss * (1.0f / 128.0f) + EPS);
            const float* g = isq ? qn : kn;
            const f32x4 ga = *(const f32x4*)(g + e1), gb = *(const f32x4*)(g + e1 + 4), gc = *(const f32x4*)(g + e2), gd = *(const f32x4*)(g + e2 + 4);
#pragma unroll
            for (int i = 0; i < 4; ++i) { x1[i] *= rstd * ga[i]; x1[4 + i] *= rstd * gb[i]; x2[i] *= rstd * gc[i]; x2[4 + i] *= rstd * gd[i]; }
        }
        const f32x4 c0 = *(const f32x4*)ct, c1 = *(const f32x4*)(ct + 4), s0 = *(const f32x4*)st, s1 = *(const f32x4*)(st + 4);
        float o1[8], o2[8];
#pragma unroll
        for (int i = 0; i < 4; ++i) { o1[i] = x1[i] * c0[i] - x2[i] * s0[i]; o2[i] = x2[i] * c0[i] + x1[i] * s0[i]; o1[4 + i] = x1[4 + i] * c1[i] - x2[4 + i] * s1[i]; o2[4 + i] = x2[4 + i] * c1[i] + x1[4 + i] * s1[i]; }
        v4u r1, r2; r1.x = pk2(o1[0], o1[1]); r1.y = pk2(o1[2], o1[3]); r1.z = pk2(o1[4], o1[5]); r1.w = pk2(o1[6], o1[7]);
        r2.x = pk2(o2[0], o2[1]); r2.y = pk2(o2[2], o2[3]); r2.z = pk2(o2[4], o2[5]); r2.w = pk2(o2[6], o2[7]);
        *(v4u*)(zp + e1) = r1; *(v4u*)(zp + e2) = r2;
    }
}

__device__ __forceinline__ void attn_phase(const bf16* z, bf16* oab, const float* sink, char* lds, int c, int G) {
    const int x = c & 7, jj = c >> 3, per = (G - x + 7) >> 3;
    for (int T = jj; T < 160; T += per) { const bool pr = T < 32; const int w = T - 32, h = pr ? x : (w >> 4), qb = pr ? T : (w & 15); const size_t r0 = pr ? 0 : S0 + (size_t)x * S1;
        att::attn_body<false, 1>(z + (r0 + 256 * qb) * INW + Z_QB + h * 128, z + r0 * INW + Z_KB + (h >> 2) * 128, z + r0 * INW + Z_VB + (h >> 2) * 128,
                                 oab + (r0 + 256 * qb) * DM + 1024 + h * 128, pr ? S0 / 64 : S1 / 64, 0, 0.f, lds); }
    for (int LL = jj; LL < 160; LL += per) { const int pm = (LL >> 3) * 8 + x, h = LL & 7; const int row0 = 256 * pm;
        const int s0 = row0 < S0 ? 0 : S0 + ((row0 - S0) & ~(S1 - 1)), S = row0 < S0 ? S0 : S1, i0 = row0 - s0;
        const int klo = i0 - 128 < 0 ? 0 : i0 - 128, khi = i0 + 384 > S ? S : i0 + 384;
        att::attn_body<true, 1>(z + (size_t)row0 * INW + Z_QA + h * 128, z + (size_t)(s0 + klo) * INW + Z_KA + (h >> 2) * 128, z + (size_t)(s0 + klo) * INW + Z_VA + (h >> 2) * 128,
                                oab + (size_t)row0 * DM + h * 128, (khi - klo) / 64, klo - i0, sink[h], lds); }
}

typedef const __attribute__((address_space(4))) Args* KArgs;
__device__ __forceinline__ KArgs kargs() { KArgs p = (KArgs)__builtin_amdgcn_kernarg_segment_ptr(); asm volatile("" : "+s"(p)); return p; }
#ifndef MK_KIND_MASK
#define MK_KIND_MASK 0x7ff
#endif
#define KIND(n) ((MK_KIND_MASK >> (n)) & 1)
__global__ void __launch_bounds__(NWAVES * 64, 2) mk_fwd(Args args_unused) {
    extern __shared__ __attribute__((aligned(16))) unsigned char lds[];
    LAS unsigned char* L = (LAS unsigned char*)lds;
    volatile LAS unsigned* MISC = (volatile LAS unsigned*)(L + MISC_OFF);
    const int G = gridDim.x, bx = blockIdx.x, ngw = G * NWAVES;
#define PHASE_IDS int tid = threadIdx.x; asm volatile("" : "+v"(tid)); const int lane = tid & 63, wave = __builtin_amdgcn_readfirstlane(tid >> 6), gw = bx * NWAVES + wave; (void)lane; (void)gw
    for (int u = threadIdx.x; u < (LDS_BYTES - LDSCTL_OFF) / 4; u += NWAVES * 64) ((LAS unsigned*)(L + LDSCTL_OFF))[u] = 0u;
    __syncthreads();
    int lo, hi; XcdBarrier bar;
    { KArgs ap = kargs(); lo = ap->ph_lo; hi = ap->ph_hi; unsigned* bw = (unsigned*)(ap->ws + WS_CTL) + CW_BAR + ap->li * XCD_BAR_WORDS;
      bar.bar = bw; bar.x = 0; bar.st = nullptr; if (hi - lo > 1) bar = xcd_barrier_post(bw, MISC + 8); }
#define IN(k) (lo <= (k) && (k) < hi)
#define SEAM(k) do { if ((k) + 1 < hi) xcd_barrier(bar); } while (0)
#define WSP(T, off) ((T*)(ap->ws + (off)))

    if (KIND(0) && IN(PH_PRO)) {
        KArgs ap = kargs(); PHASE_IDS;
        p0_tables(WSP(float, WS_TAB), bx * 512 + tid, G * 512);
        for (int it = bx; it < DEPTH * (NMOD / 256); it += G) p0_mod_item(ap->in[2], ap->in[3], ap->in[8], ap->in[9], WSP(float, WS_MOD), (LAS float*)(L + RING_OFF), it, tid, wave, lane);
        p0_transposes(ap, WSP(bf16, WS_WT), (LAS float*)(L + RING_OFF + wave * 16384), gw, ngw, lane);
        SEAM(PH_PRO);
    }
    if (KIND(1) && IN(PH_NORM0)) {
        KArgs ap = kargs(); PHASE_IDS; const float* mod = WSP(float, WS_MOD);
        norm_phase<0, true>(ap->in[0], ap->in[1], ap->out, nullptr, WSP(bf16, WS_U), nullptr, nullptr, ap->in[4], mod + 1 * DM, mod + 0 * DM, gw, ngw, lane);
        SEAM(PH_NORM0);
    }
    for (int l = 0; l < DEPTH; ++l) {
        const int pb = PH_L0 + PH_PER_LAYER * l;
        if (KIND(2) && IN(pb + 0)) {
            KArgs ap = kargs(); PHASE_IDS;
            pg8::Gemm g{WSP(bf16, WS_U), WSP(bf16, WS_WT) + (size_t)l * LAYER_W + W_IN, NTOK, INW, DM}; pg8::StaticOrder S; S.init(NTOK, INW, G, bx);
            pg8::EpiPlain E{WSP(bf16, WS_Z), INW};
            pg8::gemm_phase<pg8::EpiPlain, pg8::StaticOrder, true, true>(L + RING_OFF, g, S, E);
            SEAM(pb + 0);
        }
        if (KIND(3) && IN(pb + 1)) {
            KArgs ap = kargs(); PHASE_IDS;
            prep_phase(WSP(bf16, WS_Z), WSP(float, WS_TAB), ap->in[11] + l * 128, ap->in[12] + l * 128, gw, ngw, lane);
            SEAM(pb + 1);
        }
        if (KIND(4) && IN(pb + 2)) {
            KArgs ap = kargs(); PHASE_IDS;
            attn_phase(WSP(bf16, WS_Z), WSP(bf16, WS_O), ap->in[13] + l * 8, (char*)lds + RING_OFF, bx, G);
            SEAM(pb + 2);
        }
        if (KIND(5) && IN(pb + 3)) {
            KArgs ap = kargs(); PHASE_IDS;
            pg8::Gemm g{WSP(bf16, WS_O), WSP(bf16, WS_WT) + (size_t)l * LAYER_W + W_BR, NTOK, DM, DM}; pg8::StaticOrder S; S.init(NTOK, DM, G, bx);
            pg8::EpiMerge E{WSP(bf16, WS_MG), DM, 1024 / pg8::BK, WSP(bf16, WS_Z), INW, Z_GA, Z_GB};
            pg8::gemm_phase<pg8::EpiMerge, pg8::StaticOrder, true, true>(L + RING_OFF, g, S, E);
            SEAM(pb + 3);
        }
        if (KIND(6) && IN(pb + 4)) {
            KArgs ap = kargs(); PHASE_IDS;
            pg8::Gemm g{WSP(bf16, WS_MG), WSP(bf16, WS_WT) + (size_t)l * LAYER_W + W_OUT, NTOK, DM, DM}; pg8::StaticOrder S; S.init(NTOK, DM, G, bx);
            pg8::EpiPlain E{WSP(bf16, WS_O), DM};
            pg8::gemm_phase<pg8::EpiPlain, pg8::StaticOrder, true, true>(L + RING_OFF, g, S, E);
            SEAM(pb + 4);
        }
        if (KIND(7) && IN(pb + 5)) {
            KArgs ap = kargs(); PHASE_IDS; const float* modl = WSP(float, WS_MOD) + (size_t)l * NBATCH * NMOD;
            norm_phase<1, true>(nullptr, nullptr, ap->out, WSP(bf16, WS_O), WSP(bf16, WS_U), ap->in[5] + l * DM, modl + 2 * DM, ap->in[6] + l * DM, modl + 4 * DM, modl + 3 * DM, gw, ngw, lane);
            SEAM(pb + 5);
        }
        if (KIND(8) && IN(pb + 6)) {
            KArgs ap = kargs(); PHASE_IDS;
            pg8::Gemm g{WSP(bf16, WS_U), WSP(bf16, WS_WT) + (size_t)l * LAYER_W + W_13, NTOK, 2 * DFF, DM}; pg8::StaticOrder S; S.init(NTOK, 2 * DFF, G, bx);
            pg8::EpiSwiglu E{WSP(bf16, WS_Z), DFF};
            pg8::gemm_phase<pg8::EpiSwiglu, pg8::StaticOrder, true, true>(L + RING_OFF, g, S, E);
            SEAM(pb + 6);
        }
        if (KIND(9) && IN(pb + 7)) {
            KArgs ap = kargs(); PHASE_IDS;
            pg8::Gemm g{WSP(bf16, WS_Z), WSP(bf16, WS_WT) + (size_t)l * LAYER_W + W_2, NTOK, DM, DFF}; pg8::StaticOrder S; S.init(NTOK, DM, G, bx);
            pg8::EpiPlain E{WSP(bf16, WS_O), DM};
            pg8::gemm_phase<pg8::EpiPlain, pg8::StaticOrder, true, true>(L + RING_OFF, g, S, E);
            SEAM(pb + 7);
        }
        if (KIND(10) && IN(pb + 8)) {
            KArgs ap = kargs(); PHASE_IDS; const float* modl = WSP(float, WS_MOD) + (size_t)l * NBATCH * NMOD;
            if (l + 1 < DEPTH) { const float* modn = modl + (size_t)NBATCH * NMOD;
                norm_phase<1, true>(nullptr, nullptr, ap->out, WSP(bf16, WS_O), WSP(bf16, WS_U), ap->in[7] + l * DM, modl + 5 * DM, ap->in[4] + (l + 1) * DM, modn + 1 * DM, modn + 0 * DM, gw, ngw, lane); }
            else norm_phase<1, false>(nullptr, nullptr, ap->out, WSP(bf16, WS_O), WSP(bf16, WS_U), ap->in[7] + l * DM, modl + 5 * DM, nullptr, nullptr, nullptr, gw, ngw, lane);
            SEAM(pb + 8);
        }
    }
#undef IN
#undef SEAM
#undef WSP
#undef PHASE_IDS
}

extern "C" void kernel_launch(void* const* d_in, const int* in_sizes, int n_in, void* d_out, int out_size, void* d_ws, size_t ws_size, hipStream_t stream) {
    static int grid = 0;
    if (grid == 0) {
        if (n_in != 19 || out_size != NTOK * DM || ws_size < WS_END) { fprintf(stderr, "kernel_launch: unexpected shapes (n_in %d out %d ws %zu, need ws >= %zu); nothing launched\n", n_in, out_size, ws_size, (size_t)WS_END); grid = -1; return; }
        int dev = 0, cus = 0, per_cu = 0;
        if (hipGetDevice(&dev) != hipSuccess || hipDeviceGetAttribute(&cus, hipDeviceAttributeMultiprocessorCount, dev) != hipSuccess) { grid = -1; return; }
        if (hipFuncSetAttribute((const void*)mk_fwd, hipFuncAttributeMaxDynamicSharedMemorySize, LDS_BYTES) != hipSuccess) { fprintf(stderr, "kernel_launch: hipFuncSetAttribute failed\n"); grid = -1; return; }
        if (hipOccupancyMaxActiveBlocksPerMultiprocessor(&per_cu, (const void*)mk_fwd, NWAVES * 64, LDS_BYTES) != hipSuccess || per_cu < 1) { fprintf(stderr, "kernel_launch: occupancy query says %d blocks per CU\n", per_cu); }
        (void)hipGetLastError();
        grid = cus;
    }
    if (grid < 0) return;
    if (hipMemsetAsync((char*)d_ws + WS_CTL, 0, CTL_ZERO_BYTES, stream) != hipSuccess) return;
    Args a{};
    for (int i = 0; i < 19; ++i) a.in[i] = (const float*)d_in[i];
    a.out = (float*)d_out; a.ws = (unsigned char*)d_ws;
#if MK_LAUNCH_MODE == 1
    a.ph_lo = 0; a.ph_hi = N_PHASES; a.li = 0; a.pad = 0;
    hipLaunchKernelGGL(mk_fwd, dim3(grid), dim3(NWAVES * 64), LDS_BYTES, stream, a);
#else
    for (int p = 0; p < N_PHASES; ++p) { a.ph_lo = p; a.ph_hi = p + 1; a.li = 0; a.pad = 0;
        hipLaunchKernelGGL(mk_fwd, dim3(grid), dim3(NWAVES * 64), LDS_BYTES, stream, a); }
#endif
    const hipError_t le = hipPeekAtLastError();
    if (le != hipSuccess) fprintf(stderr, "kernel_launch: launch failed: %s\n", hipGetErrorName(le));
}
```

```cpp
#include <hip/hip_runtime.h>
#include <cstdio>
#include <cstdint>
namespace pg8 {
#define PG8_LAS __attribute__((address_space(3)))
typedef unsigned short bf16_t;
typedef short bf16x8 __attribute__((ext_vector_type(8)));
typedef float f32x4 __attribute__((ext_vector_type(4)));
typedef unsigned u32x4 __attribute__((ext_vector_type(4)));
constexpr int BM = 256, BK = 64, HALF = 128, HTB = HALF * BK * 2  , STAGE_BYTES = 8 * HTB, NXCD = 8, WGM = 4;

__host__ __device__ __forceinline__ int lds_byte(int r, int c) { const int st = (r >> 4) * 2 + (c >> 5), rr = r & 15, cc = c & 31, ob = rr * 64 + cc * 2; return st * 1024 + (ob ^ (((ob >> 9) & 1) << 5)); }
__host__ __device__ __forceinline__ void stage_rc(int b, int& R, int& C) { const int st = b / 1024, sb = b % 1024, swz = sb ^ (((sb >> 9) & 1) << 5); R = (st >> 1) * 16 + swz / 64; C = (st & 1) * 32 + (swz % 64) / 2; }
__host__ __device__ __forceinline__ int perm32(int rho) { const int n = rho >> 4, i = rho & 15; return 8 * (i >> 2) + 4 * n + (i & 3); }

struct Unit { int pm, pn, hf; };
struct Gemm { const bf16_t* A; const bf16_t* Bt; int M, N, K; };

struct StaticOrder {
    int nM, nN, nwg, G, c, lim;
    __host__ __device__ void init(int M, int N, int G_, int c_) { nM = M / BM; nN = N / BM; nwg = nM * nN; G = G_; c = c_; lim = nwg; }
    __host__ __device__ void split_tail() { const int full = (nwg / G) * G; if (2 * (nwg - full) <= G) lim = full; }
    __host__ __device__ void map(int wgid, Unit& u) const {
        { const int q = nwg / NXCD, r = nwg % NXCD, xcd = wgid % NXCD, off = wgid / NXCD; wgid = (xcd < r ? xcd * (q + 1) : r * (q + 1) + (xcd - r) * q) + off; }
        const int nig = WGM * nN, gid = wgid / nig, fm = gid * WGM, gsz = (nM - fm) < WGM ? (nM - fm) : WGM;
        u.pm = fm + ((wgid % nig) % gsz); u.pn = (wgid % nig) / gsz; u.hf = 0;
    }
    __host__ __device__ bool next(int i, Unit& u) const { const long L = (long)i * G + c; if (L >= lim) return false; map((int)L, u); return true; }
    __device__ __forceinline__ void a_ready(const Unit&) const {}
    __device__ __forceinline__ void done(const Unit&) const {}
};
struct TailOrder {
    StaticOrder S;
    __host__ __device__ bool next(int i, Unit& u) const { const int L = S.lim + (S.c >> 1); if (i > 0 || L >= S.nwg) return false; S.map(L, u); u.hf = S.c & 1; return true; }
    __device__ __forceinline__ void a_ready(const Unit&) const {}
    __device__ __forceinline__ void done(const Unit&) const {}
};
typedef float f32x2_t __attribute__((ext_vector_type(2))); typedef __bf16 bf16x2_t __attribute__((ext_vector_type(2)));
__device__ __forceinline__ unsigned cvt_pk_bf16(float lo, float hi) { f32x2_t v = {lo, hi}; bf16x2_t b = __builtin_convertvector(v, bf16x2_t); return __builtin_bit_cast(unsigned, b); }
typedef float f32x2 __attribute__((ext_vector_type(2)));
typedef unsigned u32x2 __attribute__((ext_vector_type(2)));
__device__ __forceinline__ float bf_lo(unsigned w) { return __uint_as_float(w << 16); }
__device__ __forceinline__ float bf_hi(unsigned w) { return __uint_as_float(w & 0xffff0000u); }
__device__ __forceinline__ float sigmoid_f(float x) { return __builtin_amdgcn_rcpf(1.0f + __builtin_amdgcn_exp2f(x * -1.4426950408889634f)); }
__device__ __forceinline__ u32x4 pack8(const f32x4 v0, const f32x4 v1) { u32x4 w; w.x = cvt_pk_bf16(v0[0], v0[1]); w.y = cvt_pk_bf16(v0[2], v0[3]); w.z = cvt_pk_bf16(v1[0], v1[1]); w.w = cvt_pk_bf16(v1[2], v1[3]); return w; }
__device__ __forceinline__ void unpack8(const u32x4 w, f32x4& v0, f32x4& v1) { v0 = (f32x4){bf_lo(w.x), bf_hi(w.x), bf_lo(w.y), bf_hi(w.y)}; v1 = (f32x4){bf_lo(w.z), bf_hi(w.z), bf_lo(w.w), bf_hi(w.w)}; }

template <bool NT> __device__ __forceinline__ void st16(bf16_t* p, const u32x4 v) { if (NT) __builtin_nontemporal_store(v, (u32x4*)p); else *(u32x4*)p = v; }
__device__ __forceinline__ unsigned dpp_ror8(unsigned v) { return (unsigned)__builtin_amdgcn_update_dpp(0, (int)v, 0x128  , 0xf, 0xf, false); }
struct EpiPlain {
    static constexpr bool PERM = true, AFTER_DRAIN = false, HAS_MID = false;
    bf16_t* O; int ldc;
    __device__ __forceinline__ void operator()(const f32x4 (&acc)[2][2][4][2], const Unit& u, int wr, int wc, int fr, int fq) const {
        const bool low = fr < 8;
        const int row0 = u.pm * BM + wr * 64 + (fr & 7), colp = u.pn * BM + wc * 64 + (low ? 0 : 32) + 8 * fq;
#pragma unroll
        for (int ai = 0; ai < 2; ++ai)
#pragma unroll
            for (int m = 0; m < 4; ++m) { bf16_t* rowp = O + (size_t)(row0 + ai * HALF + m * 16) * ldc + colp;
                const u32x4 X = pack8(acc[ai][0][m][0], acc[ai][0][m][1]), Y = pack8(acc[ai][1][m][0], acc[ai][1][m][1]);
                u32x4 S = low ? Y : X, R; R.x = dpp_ror8(S.x); R.y = dpp_ror8(S.y); R.z = dpp_ror8(S.z); R.w = dpp_ror8(S.w);
                *(u32x4*)rowp = low ? X : R;
                *(u32x4*)(rowp + (size_t)8 * ldc) = low ? R : Y; }
    }
};
#ifndef MK_NT_Z
#define MK_NT_Z false
#endif
struct EpiZ {
    static constexpr bool PERM = true, AFTER_DRAIN = false, HAS_MID = false;
    bf16_t* O; int ldc; const float* tab; const float* qn; const float* kn; PG8_LAS float* P;
    static constexpr int tab_cos1 = 0, tab_sin1 = 8192 * 64, tab_cr = 2 * 8192 * 64, tab_sr = tab_cr + 128 * 32, tab_cc = tab_sr + 128 * 32, tab_sc = tab_cc + 64 * 32;
    __device__ __forceinline__ void operator()(const f32x4 (&acc)[2][2][4][2], const Unit& u, int wr, int wc, int fr, int fq) const { body<2>(acc, u, 0, wr, wc, fr, fq); }
    __device__ __forceinline__ void half(const f32x4 (&acc)[2][2][4][2], const Unit& u, int wr, int wc, int fr, int fq) const { body<1>(acc, u, u.hf * HALF, wr, wc, fr, fq); }
    template <int NAI> __device__ __forceinline__ void body(const f32x4 (&acc)[2][2][4][2], const Unit& u, const int rofs, int wr, int wc, int fr, int fq) const {
        asm volatile("" : "+v"(fr), "+v"(fq));
        const int row0 = u.pm * BM + rofs + wr * 64 + fr, col0 = u.pn * BM + wc * 32 + 8 * fq;
        const int kind = (u.pn <= 4) ? 1 : ((u.pn >= 6 && u.pn <= 10) ? 2 : 0);
        if (kind == 0) {
            if (u.pn >= 12) {
                const int cg = (u.pn - 12) * 4 + wc;
                const size_t gbase = (size_t)((u.pm * 16 + (rofs >> 4) + wr * 4) * 16 + (cg >> 3)) * ldc + 3072 + (cg & 7) * 512 + (fq * 16 + fr) * 8;
#pragma unroll
                for (int ai = 0; ai < NAI; ++ai)
#pragma unroll
                    for (int m = 0; m < 4; ++m) { bf16_t* rowp = O + gbase + (size_t)((ai * 8 + m) * 16) * ldc;
                        f32x4 r0, r1, s0, s1;
#pragma unroll
                        for (int j = 0; j < 4; ++j) {
                            const float ea0 = __builtin_amdgcn_exp2f(__builtin_amdgcn_fmed3f(acc[ai][0][m][0][j] * -1.4426950408889634f, -60.f, 60.f)), ea1 = __builtin_amdgcn_exp2f(__builtin_amdgcn_fmed3f(acc[ai][0][m][1][j] * -1.4426950408889634f, -60.f, 60.f));
                            const float eb0 = __builtin_amdgcn_exp2f(__builtin_amdgcn_fmed3f(acc[ai][1][m][0][j] * -1.4426950408889634f, -60.f, 60.f)), eb1 = __builtin_amdgcn_exp2f(__builtin_amdgcn_fmed3f(acc[ai][1][m][1][j] * -1.4426950408889634f, -60.f, 60.f));
                            r0[j] = (1.0f + eb0) * __builtin_amdgcn_rcpf(1.0f + ea0); r1[j] = (1.0f + eb1) * __builtin_amdgcn_rcpf(1.0f + ea1);
                            s0[j] = __builtin_amdgcn_rcpf(1.0f + eb0); s1[j] = __builtin_amdgcn_rcpf(1.0f + eb1); }
                        st16<MK_NT_Z>(rowp, pack8(r0, r1)); st16<MK_NT_Z>(rowp + (size_t)8 * ldc, pack8(s0, s1)); }
                return;
            }
#pragma unroll
            for (int ai = 0; ai < NAI; ++ai)
#pragma unroll
                for (int m = 0; m < 4; ++m) { bf16_t* rowp = O + (size_t)(row0 + ai * HALF + m * 16) * ldc + col0;
#pragma unroll
                    for (int bj = 0; bj < 2; ++bj) st16<MK_NT_Z>(rowp + bj * HALF, pack8(acc[ai][bj][m][0], acc[ai][bj][m][1])); }
            return;
        }
        const int g = 4 * wc + fq;
        const int prow0 = u.pm * BM;
        const int pos0 = (prow0 < 8192 ? prow0 : ((prow0 - 8192) & 4095)) + rofs + wr * 64 + fr;
        if (kind == 1) {
            f32x4 cc[2][4], sn[2][4];
#pragma unroll
            for (int ai = 0; ai < NAI; ++ai)
#pragma unroll
                for (int m = 0; m < 4; ++m) { const int pos = pos0 + ai * HALF + m * 16; const int ix = (((pos >> 4) * 16 + g) * 16 + (pos & 15)) * 4; cc[ai][m] = *(const f32x4*)(tab + tab_cos1 + ix); sn[ai][m] = *(const f32x4*)(tab + tab_sin1 + ix); }
#pragma unroll
            for (int ai = 0; ai < NAI; ++ai)
#pragma unroll
                for (int m = 0; m < 4; ++m) { bf16_t* rowp = O + (size_t)(row0 + ai * HALF + m * 16) * ldc + col0; const f32x4 c = cc[ai][m], s = sn[ai][m];
#pragma unroll
                    for (int bj = 0; bj < 2; ++bj) { const f32x4 v0 = acc[ai][bj][m][0], v1 = acc[ai][bj][m][1];
                        st16<MK_NT_Z>(rowp + bj * HALF, pack8(v0 * c - v1 * s, v1 * c + v0 * s)); } }
            return;
        }
        float ss[2][4][2];
#pragma unroll
        for (int ai = 0; ai < NAI; ++ai)
#pragma unroll
            for (int m = 0; m < 4; ++m)
#pragma unroll
                for (int bj = 0; bj < 2; ++bj) { const f32x4 a = acc[ai][bj][m][0], b = acc[ai][bj][m][1];
                    float t = (a[0] * a[0] + a[1] * a[1]) + (a[2] * a[2] + a[3] * a[3]) + (b[0] * b[0] + b[1] * b[1]) + (b[2] * b[2] + b[3] * b[3]);
                    t += __shfl_xor(t, 16); t += __shfl_xor(t, 32); ss[ai][m][bj] = t;
                    if (fq == 0) P[((ai * HALF + wr * 64 + m * 16 + fr) * 2 + bj) * 4 + wc] = t; }
        asm volatile("s_waitcnt lgkmcnt(0)" ::: "memory"); __builtin_amdgcn_s_barrier(); asm volatile("" ::: "memory");
        const float* gn = (u.pn == 10) ? kn : qn; const float kmul = (u.pn == 10) ? 0.12751743082459868f : 1.0f;
        const int gg = g & 7, n0 = (g < 8) ? 4 * g : 64 + 4 * gg;
        const f32x4 g0 = *(const f32x4*)(gn + n0), g1 = *(const f32x4*)(gn + n0 + 32);
#pragma unroll
        for (int ai = 0; ai < NAI; ++ai)
#pragma unroll
            for (int m = 0; m < 4; ++m) { const int pos = pos0 + ai * HALF + m * 16; bf16_t* rowp = O + (size_t)(row0 + ai * HALF + m * 16) * ldc + col0;
                const int toff = (g < 8) ? (pos >> 6) * 32 + 4 * gg : ((((pos & 63) >> 4) * 8 + gg) * 16 + (pos & 15)) * 4;
                const f32x4 c = *(const f32x4*)(tab + ((g < 8) ? tab_cr : tab_cc) + toff), s = *(const f32x4*)(tab + ((g < 8) ? tab_sr : tab_sc) + toff);
#pragma unroll
                for (int bj = 0; bj < 2; ++bj) { const f32x4 pp = *(const PG8_LAS f32x4*)(P + ((ai * HALF + wr * 64 + m * 16 + fr) * 2 + bj) * 4);
                    const float rstd = __builtin_amdgcn_rsqf(((pp[0] + pp[1]) + (pp[2] + pp[3])) * (1.0f / 128.0f) + 1e-6f) * kmul;
                    const f32x4 v0 = acc[ai][bj][m][0] * g0 * rstd, v1 = acc[ai][bj][m][1] * g1 * rstd;
                    st16<MK_NT_Z>(rowp + bj * HALF, pack8(v0 * c - v1 * s, v1 * c + v0 * s)); } }
    }
};
struct EpiSwiglu {
    static constexpr bool PERM = true, AFTER_DRAIN = false, HAS_MID = false;
    bf16_t* O; int ldc;
    __device__ __forceinline__ void operator()(const f32x4 (&acc)[2][2][4][2], const Unit& u, int wr, int wc, int fr, int fq) const { body<2>(acc, u, 0, wr, wc, fr, fq); }
    __device__ __forceinline__ void half(const f32x4 (&acc)[2][2][4][2], const Unit& u, int wr, int wc, int fr, int fq) const { body<1>(acc, u, u.hf * 8, wr, wc, fr, fq); }
    template <int NAI> __device__ __forceinline__ void body(const f32x4 (&acc)[2][2][4][2], const Unit& u, const int r16, int wr, int wc, int fr, int fq) const {
        const size_t base = (size_t)(u.pm * 16 + r16 + wr * 4) * 16 * ldc + (size_t)(u.pn * 4 + wc) * 512 + (fr & 7) * 64 + (fr >> 3) * 32 + 8 * fq;
#pragma unroll
        for (int ai = 0; ai < NAI; ++ai)
#pragma unroll
            for (int m = 0; m < 4; ++m) { bf16_t* p = O + base + (size_t)(ai * 8 + m) * 16 * ldc;
                f32x4 h[2];
#pragma unroll
                for (int n = 0; n < 2; ++n) { const f32x4 a = acc[ai][0][m][n], b = acc[ai][1][m][n];
#pragma unroll
                    for (int j = 0; j < 4; ++j) h[n][j] = a[j] * sigmoid_f(a[j]) * b[j]; }
                st16<MK_NT_Z>(p, pack8(h[0], h[1])); }
    }
};
struct EpiMerge {
    static constexpr bool PERM = true, AFTER_DRAIN = false, HAS_MID = true;
    bf16_t* O; int ldc; int mid_t; const bf16_t* Z; int ldz; int ga_off, gb_off;
    __device__ __forceinline__ void mid(f32x4 (&acc)[2][2][4][2], const Unit& u, int wr, int wc, int fr, int fq) const {
        int lane8 = (fq * 16 + fr) * 8;
        asm volatile("" : "+v"(lane8));
        u32x4 wa[2][4][2];
        const size_t gb0 = (size_t)((u.pm * 16 + wr * 4) * 16 + u.pn) * ldz + ga_off + wc * 512 + lane8;
#pragma unroll
        for (int ai = 0; ai < 2; ++ai)
#pragma unroll
            for (int m = 0; m < 4; ++m) { const bf16_t* zr = Z + gb0 + (size_t)((ai * 8 + m) * 16) * ldz;
#pragma unroll
                for (int bj = 0; bj < 2; ++bj) wa[ai][m][bj] = *(const u32x4*)(zr + bj * 2048); }
#pragma unroll
        for (int ai = 0; ai < 2; ++ai)
#pragma unroll
            for (int m = 0; m < 4; ++m)
#pragma unroll
                for (int bj = 0; bj < 2; ++bj) { f32x4 a0, a1; unpack8(wa[ai][m][bj], a0, a1); acc[ai][bj][m][0] *= a0; acc[ai][bj][m][1] *= a1; }
    }
    __device__ __forceinline__ void operator()(const f32x4 (&acc)[2][2][4][2], const Unit& u, int wr, int wc, int fr, int fq) const {
        const int row0 = u.pm * BM + wr * 64 + fr, col0 = u.pn * BM + wc * 32 + 8 * fq;
        u32x4 wb[2][4][2];
#pragma unroll
        for (int ai = 0; ai < 2; ++ai)
#pragma unroll
            for (int m = 0; m < 4; ++m) { const bf16_t* zr = Z + (size_t)((u.pm * 16 + wr * 4 + ai * 8 + m) * 16 + u.pn + 8) * ldz + ga_off + wc * 512 + (fq * 16 + fr) * 8;
#pragma unroll
                for (int bj = 0; bj < 2; ++bj) wb[ai][m][bj] = *(const u32x4*)(zr + bj * 2048); }
#pragma unroll
        for (int ai = 0; ai < 2; ++ai)
#pragma unroll
            for (int m = 0; m < 4; ++m) { bf16_t* rowp = O + (size_t)(row0 + ai * HALF + m * 16) * ldc + col0;
#pragma unroll
                for (int bj = 0; bj < 2; ++bj) { f32x4 b0, b1; unpack8(wb[ai][m][bj], b0, b1);
                    *(u32x4*)(rowp + bj * HALF) = pack8(acc[ai][bj][m][0] * b0, acc[ai][bj][m][1] * b1); } }
    }
};

template <class Epi, class Sched, bool ALIGN_EPI = false, bool SP2 = false, bool ABL = false, bool HU = false>
__device__ __forceinline__ void gemm_phase(PG8_LAS unsigned char* lds, const Gemm g, const Sched& S, const Epi& E) {
    int tid = threadIdx.x; asm volatile("" : "+v"(tid));
    const int wid = __builtin_amdgcn_readfirstlane(tid >> 6), lane = tid & 63, wr = wid >> 2, wc = wid & 3, fr = lane & 15, fq = lane >> 4;
    const int K = g.K, nt = K / BK;
    unsigned voffA[2], voffB[2];
#pragma unroll
    for (int i = 0; i < 2; ++i) { int R, C; stage_rc(tid * 16 + i * 8192, R, C); const int Rb = Epi::PERM ? ((R & ~31) + perm32(R & 31)) : R;
        voffA[i] = ABL ? (unsigned)((R >> 4) * (16 * K) + (C >> 5) * 512 + (R & 7) * 64 + ((R >> 3) & 1) * 32 + (C & 31)) * 2u : (unsigned)(R * K + C) * 2u; voffB[i] = (unsigned)(Rb * K + C) * 2u; }
    const size_t kstep = (size_t)(BK * 2);
    const size_t kstepA = ABL ? (size_t)(BK / 32) * 1024 : kstep;
    const size_t hstep = (size_t)HALF * K * 2;
    unsigned voffA1[2] = {HU ? 0u : voffA[0], HU ? 0u : voffA[1]};
    const size_t hstepA = HU ? 0 : hstep; static_assert(!HU || (SP2 && !ABL && !Epi::HAS_MID), "HALF units: SP2 schedule, row-major A, no mid hook");
    const size_t tstep = 2 * hstep;
    const unsigned ldsw = (unsigned)wid * 1024u;
    const int aoff = lds_byte(wr * 64 + fr, fq * 8), boff = lds_byte(wc * 32 + fr, fq * 8);
#define PG8_SA(b, h) (((b) * 2 + (h)) * HTB)
#define PG8_SB(b, h) ((4 + (b) * 2 + (h)) * HTB)
#define PG8_STAGE(bufoff, gbase, voff) do { _Pragma("unroll") for (int _i = 0; _i < 2; ++_i) \
        __builtin_amdgcn_global_load_lds((const unsigned*)((const char*)(gbase) + (voff)[_i]), (PG8_LAS unsigned*)(lds + (bufoff) + ldsw + _i * 8192), 16, 0, 0); } while (0)
#define PG8_LDA(dst, b, h) do { _Pragma("unroll") for (int m = 0; m < 4; ++m) _Pragma("unroll") for (int k = 0; k < 2; ++k) dst[m][k] = *(const PG8_LAS bf16x8*)(lds + PG8_SA(b, h) + aoff + m * 2048 + k * 1024); } while (0)
#define PG8_LDB(dst, b, h) do { _Pragma("unroll") for (int n = 0; n < 2; ++n) _Pragma("unroll") for (int k = 0; k < 2; ++k) dst[n][k] = *(const PG8_LAS bf16x8*)(lds + PG8_SB(b, h) + boff + n * 2048 + k * 1024); } while (0)
#define PG8_MMA(ai, bj, At, Bt) do { __builtin_amdgcn_s_setprio(1); _Pragma("unroll") for (int m = 0; m < 4; ++m) _Pragma("unroll") for (int n = 0; n < 2; ++n) _Pragma("unroll") for (int k = 0; k < 2; ++k) \
        acc[ai][bj][m][n] = __builtin_amdgcn_mfma_f32_16x16x32_bf16(Bt[n][k], At[m][k], acc[ai][bj][m][n], 0, 0, 0); __builtin_amdgcn_s_setprio(0); } while (0)
#define PG8_WAIT_V(n) asm volatile("s_waitcnt vmcnt(" #n ")" ::: "memory")
#define PG8_WAIT_L(n) asm volatile("s_waitcnt lgkmcnt(" #n ")" ::: "memory")
#define PG8_BAR __builtin_amdgcn_s_barrier()
#define PG8_SCHED __builtin_amdgcn_sched_barrier(0)
    Unit cur, nxt; int ui = 0;
    if (!S.next(0, cur)) return;
    f32x4 acc[2][2][4][2];
#pragma unroll
    for (int a = 0; a < 2; ++a)
#pragma unroll
        for (int b = 0; b < 2; ++b)
#pragma unroll
            for (int m = 0; m < 4; ++m)
#pragma unroll
                for (int n = 0; n < 2; ++n) acc[a][b][m][n] = (f32x4){0.f, 0.f, 0.f, 0.f};
    bf16x8 At[4][2], B0[2][2], B1[2][2];
    const char* cA = (const char*)g.A + (size_t)cur.pm * tstep + (HU ? (size_t)cur.hf * hstep : 0); const char* cB = (const char*)g.Bt + (size_t)cur.pn * tstep;
    S.a_ready(cur);
    if constexpr (SP2) {
        PG8_STAGE(PG8_SB(0, 0), cB, voffB); PG8_STAGE(PG8_SB(0, 1), cB + hstep, voffB); PG8_STAGE(PG8_SA(0, 0), cA, voffA); PG8_STAGE(PG8_SA(0, 1), cA + hstepA, voffA1);
        if (wr == 1) PG8_BAR;
        PG8_WAIT_V(2); PG8_BAR;
        PG8_STAGE(PG8_SB(1, 0), cB + kstep, voffB); PG8_STAGE(PG8_SA(1, 0), cA + kstepA, voffA); PG8_STAGE(PG8_SB(1, 1), cB + hstep + kstep, voffB);
        PG8_WAIT_V(6); PG8_BAR;
    } else {
        PG8_STAGE(PG8_SB(0, 0), cB, voffB); PG8_STAGE(PG8_SA(0, 0), cA, voffA); PG8_STAGE(PG8_SB(0, 1), cB + hstep, voffB); PG8_STAGE(PG8_SA(0, 1), cA + hstep, voffA);
        if (wr == 1) PG8_BAR;
        PG8_WAIT_V(4); PG8_BAR;
        PG8_STAGE(PG8_SB(1, 0), cB + kstep, voffB); PG8_STAGE(PG8_SA(1, 0), cA + kstepA, voffA); PG8_STAGE(PG8_SB(1, 1), cB + hstep + kstep, voffB);
        PG8_WAIT_V(6); PG8_BAR;
    }
    for (;;) {
        const bool has_next = S.next(ui + 1, nxt);
        const char* nA = has_next ? (const char*)g.A + (size_t)nxt.pm * tstep + (HU ? (size_t)nxt.hf * hstep : 0) : cA; const char* nB = has_next ? (const char*)g.Bt + (size_t)nxt.pn * tstep : cB;
        for (int t = 0; t < nt; t += 2) {
            const bool last = (t == nt - 2);
            if constexpr (Epi::HAS_MID) { if (t == E.mid_t) E.mid(acc, cur, wr, wc, fr, fq); }
            const char* a1 = cA + (size_t)(t + 1) * kstepA;
            const char* a2 = last ? nA : cA + (size_t)(t + 2) * kstepA; const char* b2 = last ? nB : cB + (size_t)(t + 2) * kstep;
            const char* a3 = a2 + kstepA; const char* b3 = b2 + kstep;
            if (last && has_next) S.a_ready(nxt);
            if constexpr (SP2) {
            PG8_LDB(B0, 0, 0); PG8_LDB(B1, 0, 1); PG8_SCHED; PG8_LDA(At, 0, 0); PG8_STAGE(PG8_SA(1, 1), a1 + hstepA, voffA1);
            PG8_WAIT_V(8); PG8_WAIT_L(0); PG8_BAR; PG8_MMA(0, 0, At, B0); PG8_MMA(0, 1, At, B1); PG8_BAR; PG8_SCHED;
            if constexpr (!HU) PG8_LDA(At, 0, 1); PG8_STAGE(PG8_SB(0, 0), b2, voffB); PG8_STAGE(PG8_SB(0, 1), b2 + hstep, voffB); PG8_STAGE(PG8_SA(0, 0), a2, voffA);
            PG8_WAIT_V(8); PG8_WAIT_L(0); PG8_BAR; if constexpr (!HU) { PG8_MMA(1, 0, At, B0); PG8_MMA(1, 1, At, B1); } PG8_BAR; PG8_SCHED;
            PG8_LDB(B0, 1, 0); PG8_LDB(B1, 1, 1); PG8_SCHED; PG8_LDA(At, 1, 0); PG8_STAGE(PG8_SA(0, 1), a2 + hstepA, voffA1);
            PG8_WAIT_V(8); PG8_WAIT_L(0); PG8_BAR; PG8_MMA(0, 0, At, B0); PG8_MMA(0, 1, At, B1); PG8_BAR; PG8_SCHED;
            if constexpr (!HU) PG8_LDA(At, 1, 1); PG8_STAGE(PG8_SB(1, 0), b3, voffB); PG8_STAGE(PG8_SB(1, 1), b3 + hstep, voffB); PG8_STAGE(PG8_SA(1, 0), a3, voffA);
            PG8_WAIT_V(8); PG8_WAIT_L(0); PG8_BAR; if constexpr (!HU) { PG8_MMA(1, 0, At, B0); PG8_MMA(1, 1, At, B1); } PG8_BAR; PG8_SCHED;
            } else {
            PG8_LDB(B0, 0, 0); PG8_SCHED; PG8_LDA(At, 0, 0); PG8_STAGE(PG8_SA(1, 1), a1 + hstep, voffA);
            PG8_WAIT_L(8); PG8_BAR; PG8_WAIT_L(0); PG8_MMA(0, 0, At, B0); PG8_BAR; PG8_SCHED;
            PG8_LDB(B1, 0, 1); PG8_STAGE(PG8_SB(0, 0), b2, voffB);
            PG8_BAR; PG8_WAIT_L(0); PG8_MMA(0, 1, At, B1); PG8_BAR;
            PG8_LDA(At, 0, 1); PG8_STAGE(PG8_SA(0, 0), a2, voffA);
            PG8_BAR; PG8_WAIT_L(0); PG8_MMA(1, 0, At, B0); PG8_BAR; PG8_SCHED;
            PG8_STAGE(PG8_SB(0, 1), b2 + hstep, voffB);
            PG8_WAIT_V(6); PG8_BAR; PG8_MMA(1, 1, At, B1); PG8_BAR;
            PG8_LDB(B0, 1, 0); PG8_SCHED; PG8_LDA(At, 1, 0); PG8_STAGE(PG8_SA(0, 1), a2 + hstep, voffA);
            PG8_WAIT_L(8); PG8_BAR; PG8_WAIT_L(0); PG8_MMA(0, 0, At, B0); PG8_BAR; PG8_SCHED;
            PG8_LDB(B1, 1, 1); PG8_STAGE(PG8_SB(1, 0), b3, voffB);
            PG8_BAR; PG8_WAIT_L(0); PG8_MMA(0, 1, At, B1); PG8_BAR;
            PG8_LDA(At, 1, 1); PG8_STAGE(PG8_SA(1, 0), a3, voffA);
            PG8_BAR; PG8_WAIT_L(0); PG8_MMA(1, 0, At, B0); PG8_BAR; PG8_SCHED;
            PG8_STAGE(PG8_SB(1, 1), b3 + hstep, voffB);
            PG8_WAIT_V(6); PG8_BAR; PG8_MMA(1, 1, At, B1); PG8_BAR;
            }
        }
        if constexpr (ALIGN_EPI) { if (wr == 0) PG8_BAR; }
        if constexpr (!Epi::AFTER_DRAIN) { if constexpr (HU) E.half(acc, cur, wr, wc, fr, fq); else E(acc, cur, wr, wc, fr, fq); S.done(cur); }
        if (!has_next) break;
#pragma unroll
        for (int a = 0; a < 2; ++a)
#pragma unroll
            for (int b = 0; b < 2; ++b)
#pragma unroll
                for (int m = 0; m < 4; ++m)
#pragma unroll
                    for (int n = 0; n < 2; ++n) acc[a][b][m][n] = (f32x4){0.f, 0.f, 0.f, 0.f};
        cur = nxt; cA = nA; cB = nB; ++ui;
        if constexpr (ALIGN_EPI) { if (wr == 1) PG8_BAR; }
    }
    PG8_WAIT_V(0);
    if constexpr (!ALIGN_EPI) { if (wr == 0) PG8_BAR; }
    PG8_BAR;
    if constexpr (Epi::AFTER_DRAIN) { E.fused(acc, cur, wr, wc, fr, fq, lds, wid, lane); S.done(cur); }
#undef PG8_SA
#undef PG8_SB
#undef PG8_STAGE
#undef PG8_LDA
#undef PG8_LDB
#undef PG8_MMA
#undef PG8_WAIT_V
#undef PG8_WAIT_L
#undef PG8_BAR
#undef PG8_SCHED
}
}
namespace att {
constexpr int   D = 128, NW = 8, QBLK = 32, KVBLK = 64;
constexpr float SCALE = 0.088388347648318440f;
constexpr float THR = 8.f;
constexpr int LDQ = 7168, LDK = 7168, LDO = 2048;
constexpr int SHM_V = KVBLK * D * 2, SHM_K = KVBLK * D * 2, SHM_ATTN = 2 * SHM_V + 2 * SHM_K + NW * 64 * 4;
typedef unsigned short bf16;
using bf16x8 = __attribute__((ext_vector_type(8))) short;
using s16x4  = __attribute__((ext_vector_type(4))) short;
using f32x16 = __attribute__((ext_vector_type(16))) float;
using u32x4  = __attribute__((ext_vector_type(4))) unsigned;
#define KSWZ(row, colB) ((row) * 256 + ((colB) ^ (((row) & 7) << 4)))
#define SBAR() __builtin_amdgcn_sched_barrier(0)
__device__ __forceinline__ int crow(int r, int hi) { return (r & 3) + 8 * (r >> 2) + 4 * hi; }
typedef float f32x2_t __attribute__((ext_vector_type(2))); typedef __bf16 bf16x2_t __attribute__((ext_vector_type(2)));
__device__ __forceinline__ unsigned cvtpk(float lo, float hi) { f32x2_t v = {lo, hi}; bf16x2_t b = __builtin_convertvector(v, bf16x2_t); return __builtin_bit_cast(unsigned, b); }

__device__ __forceinline__ void partialSM(f32x16& p0, f32x16& p1, float& m_reg, float& mn, float& alpha) {
  constexpr float C = SCALE * 1.4426950408889634f;
  float pmax = p0[0]; for (int r = 1; r < 16; ++r) pmax = fmaxf(pmax, p0[r]); for (int r = 0; r < 16; ++r) pmax = fmaxf(pmax, p1[r]);
  { auto rr = __builtin_amdgcn_permlane32_swap(__float_as_uint(pmax), __float_as_uint(pmax), false, false);
    pmax = fmaxf(__uint_as_float(rr[0]), __uint_as_float(rr[1])); }
  if (__builtin_expect(__all(pmax - m_reg <= THR / SCALE), 1)) { mn = m_reg; alpha = 1.f; }
  else { mn = fmaxf(m_reg, pmax); alpha = __builtin_amdgcn_exp2f((m_reg - mn) * C); m_reg = mn; }
  float mnC = -mn * C;
  for (int r = 0; r < 16; ++r) p0[r] = fmaf(p0[r], C, mnC); for (int r = 0; r < 16; ++r) p1[r] = fmaf(p1[r], C, mnC);
  for (int r = 0; r < 16; ++r) p0[r] = __builtin_amdgcn_exp2f(p0[r]);
}
__device__ __forceinline__ void partialSM_nomax(f32x16& p0) { for (int r = 0; r < 16; ++r) p0[r] = __builtin_amdgcn_exp2f(p0[r]); }
__device__ __forceinline__ void finishSM(f32x16& p0, f32x16& p1, float alpha, float& l_reg, bf16x8& pa0, bf16x8& pa1, bf16x8& pa2, bf16x8& pa3) {
  for (int r = 0; r < 16; ++r) p1[r] = __builtin_amdgcn_exp2f(p1[r]);
  float ps = 0; for (int r = 0; r < 16; ++r) ps += p0[r]; for (int r = 0; r < 16; ++r) ps += p1[r];
  { auto rr = __builtin_amdgcn_permlane32_swap(__float_as_uint(ps), __float_as_uint(ps), false, false);
    ps = __uint_as_float(rr[0]) + __uint_as_float(rr[1]); }
  l_reg = l_reg * alpha + ps;
#define PK4(P, BASE, OUT) do { unsigned a0 = cvtpk(P[BASE + 0], P[BASE + 1]), a1 = cvtpk(P[BASE + 2], P[BASE + 3]);   \
    unsigned b0 = cvtpk(P[BASE + 4], P[BASE + 5]), b1 = cvtpk(P[BASE + 6], P[BASE + 7]);                              \
    auto r0 = __builtin_amdgcn_permlane32_swap(a0, b0, false, false); auto r1 = __builtin_amdgcn_permlane32_swap(a1, b1, false, false); \
    u32x4 w = {r0[0], r1[0], r0[1], r1[1]}; OUT = *reinterpret_cast<bf16x8*>(&w); } while (0)
  PK4(p0, 0, pa0); PK4(p0, 8, pa1); PK4(p1, 0, pa2); PK4(p1, 8, pa3);
#undef PK4
}
__device__ __forceinline__ void qkt(f32x16& p0, f32x16& p1, const bf16* Ks, const bf16x8* qr, int r32, int hi, float init = 0.f) {
  for (int r = 0; r < 16; ++r) { p0[r] = init; p1[r] = init; }
  for (int d0 = 0; d0 < 8; ++d0) { int cb = (d0 * 16 + hi * 8) * 2;
    bf16x8 b0 = *reinterpret_cast<const bf16x8*>((const char*)Ks + KSWZ(r32, cb));
    bf16x8 b1 = *reinterpret_cast<const bf16x8*>((const char*)Ks + KSWZ(32 + r32, cb));
    p0 = __builtin_amdgcn_mfma_f32_32x32x16_bf16(b0, qr[d0], p0, 0, 0, 0);
    p1 = __builtin_amdgcn_mfma_f32_32x32x16_bf16(b1, qr[d0], p1, 0, 0, 0); }
}
__device__ __forceinline__ void wmask(f32x16& p0, f32x16& p1, int dk0, int hi) {
#pragma unroll
  for (int r = 0; r < 16; ++r) { const int d = dk0 + crow(r, hi); p0[r] = (d >= -128 && d <= 128) ? p0[r] : -1e30f; const int e = d + 32; p1[r] = (e >= -128 && e <= 128) ? p1[r] : -1e30f; }
}
__device__ __forceinline__ int v_st(int k, int c) { const int kk = (k & ~0xC) | ((k & 4) << 1) | ((k & 8) >> 1); return ((kk >> 3) * 4 + (c >> 5)) * 512 + ((kk & 7) * 32 + (c & 31)) * 2; }
__device__ __forceinline__ int v_rd_base(int lane) { return ((lane & 3) << 3) | (((lane >> 2) & 3) << 6) | (((lane >> 4) & 1) << 5) | (((lane >> 5) & 1) << 8); }
constexpr int v_rd_off(int d0, int ks, int half) { return d0 * 512 + ks * 4096 + half * 2048; }
template <int OFF> __device__ __forceinline__ s16x4 tr_read(int vb) {
  s16x4 r; asm volatile("ds_read_b64_tr_b16 %0, %1 offset:%2" : "=&v"(r) : "v"(vb), "i"(OFF) : "memory"); return r;
}
template <int D0> __device__ __forceinline__ void pv_one(f32x16& od, int vb, bf16x8 pa0, bf16x8 pa1, bf16x8 pa2, bf16x8 pa3) {
  const s16x4 l0 = tr_read<v_rd_off(D0, 0, 0)>(vb), h0 = tr_read<v_rd_off(D0, 0, 1)>(vb), l1 = tr_read<v_rd_off(D0, 1, 0)>(vb), h1 = tr_read<v_rd_off(D0, 1, 1)>(vb);
  const s16x4 l2 = tr_read<v_rd_off(D0, 2, 0)>(vb), h2 = tr_read<v_rd_off(D0, 2, 1)>(vb), l3 = tr_read<v_rd_off(D0, 3, 0)>(vb), h3 = tr_read<v_rd_off(D0, 3, 1)>(vb);
  asm volatile("s_waitcnt lgkmcnt(0)" ::: "memory"); SBAR();
#define PK(L, H) (bf16x8){L[0], L[1], L[2], L[3], H[0], H[1], H[2], H[3]}
  od = __builtin_amdgcn_mfma_f32_32x32x16_bf16(pa0, PK(l0, h0), od, 0, 0, 0);
  od = __builtin_amdgcn_mfma_f32_32x32x16_bf16(pa1, PK(l1, h1), od, 0, 0, 0);
  od = __builtin_amdgcn_mfma_f32_32x32x16_bf16(pa2, PK(l2, h2), od, 0, 0, 0);
  od = __builtin_amdgcn_mfma_f32_32x32x16_bf16(pa3, PK(l3, h3), od, 0, 0, 0);
#undef PK
}
__device__ __forceinline__ void pv_d0(f32x16* o, int vb, bf16x8 pa0, bf16x8 pa1, bf16x8 pa2, bf16x8 pa3) {
  pv_one<0>(o[0], vb, pa0, pa1, pa2, pa3); pv_one<1>(o[1], vb, pa0, pa1, pa2, pa3); pv_one<2>(o[2], vb, pa0, pa1, pa2, pa3); pv_one<3>(o[3], vb, pa0, pa1, pa2, pa3);
}

struct Stage1 { bf16x8 vs0, vs1, ks0, ks1; };
struct Carry { bf16x8 qr[8]; Stage1 st; };
template <bool WIN, int SDEPTH = 2>
__device__ __forceinline__ void attn_body(const bf16* __restrict__ Qb, const bf16* __restrict__ Kh, const bf16* __restrict__ Vh,
                                          bf16* __restrict__ Ob, int ntiles, int dq0, float sink, float sinkB, char* lds,
                                          Carry& cy, bool preloaded, const bf16* __restrict__ nQb, const bf16* __restrict__ nKh, const bf16* __restrict__ nVh, bool has_next) {
  int tid = threadIdx.x; asm volatile("" : "+v"(tid));
  const int wid = __builtin_amdgcn_readfirstlane(tid >> 6), lane = tid & 63, r32 = lane & 31, hi = lane >> 5;
  bf16* V_lds = (bf16*)lds; bf16* K_lds = (bf16*)(lds + 2 * SHM_V);
  float* ws = (float*)(lds + 2 * SHM_V + 2 * SHM_K) + wid * 64; float* li_l = ws; float* al_l = ws + 32;
  const int wrow = WIN ? (wid & 3) * QBLK : wid * QBLK, hsel = WIN ? (wid >> 2) * D : 0;
  float m_reg = WIN ? (hsel ? sinkB : sink) * (1.0f / SCALE) : -1e30f, l_reg = WIN ? 1.f : 0.f; f32x16 o[4] = {}; bf16x8 (&qr)[8] = cy.qr;
  if (!preloaded) { const bf16* Qw = Qb + (long)(wrow + r32) * LDQ + hsel + hi * 8;
#pragma unroll
    for (int d0 = 0; d0 < 8; ++d0) qr[d0] = *reinterpret_cast<const bf16x8*>(Qw + d0 * 16); }
  const int sr = tid >> 4, sc = (tid & 15) * 8, vst0 = v_st(sr, sc), vst1 = v_st(32 + sr, sc);
  const int vb0 = (int)(uintptr_t)V_lds + v_rd_base(lane);
  const int dkl = dq0 - (wrow + r32);
  static_assert(SDEPTH == 1, "cross-unit prefetch uses the single staging slot"); Stage1 (&sr_)[1] = reinterpret_cast<Stage1 (&)[1]>(cy.st);
#define SLOADP(Kp, Vp) do { sr_[0].vs0 = *reinterpret_cast<const bf16x8*>(&(Vp)[(long)sr * LDK + sc]); sr_[0].vs1 = *reinterpret_cast<const bf16x8*>(&(Vp)[(long)(32 + sr) * LDK + sc]); \
    sr_[0].ks0 = *reinterpret_cast<const bf16x8*>(&(Kp)[(long)sr * LDK + sc]); sr_[0].ks1 = *reinterpret_cast<const bf16x8*>(&(Kp)[(long)(32 + sr) * LDK + sc]); } while (0)
#define SLOAD(i, k0) do { sr_[i].vs0 = *reinterpret_cast<const bf16x8*>(&Vh[(long)((k0) + sr) * LDK + sc]); sr_[i].vs1 = *reinterpret_cast<const bf16x8*>(&Vh[(long)((k0) + 32 + sr) * LDK + sc]); \
    sr_[i].ks0 = *reinterpret_cast<const bf16x8*>(&Kh[(long)((k0) + sr) * LDK + sc]); sr_[i].ks1 = *reinterpret_cast<const bf16x8*>(&Kh[(long)((k0) + 32 + sr) * LDK + sc]); } while (0)
#define SWRITE(b, i) do { *(bf16x8*)((char*)V_lds + (b) * SHM_V + vst0) = sr_[i].vs0;          \
    *(bf16x8*)((char*)V_lds + (b) * SHM_V + vst1) = sr_[i].vs1; int kc = sc * 2;               \
    *(bf16x8*)((char*)K_lds + (b) * SHM_K + KSWZ(sr, kc)) = sr_[i].ks0;                       \
    *(bf16x8*)((char*)K_lds + (b) * SHM_K + KSWZ(32 + sr, kc)) = sr_[i].ks1; } while (0)
#define SWAIT() do { if constexpr (SDEPTH == 2) asm volatile("s_waitcnt vmcnt(4)" ::: "memory"); else asm volatile("s_waitcnt vmcnt(0)" ::: "memory"); } while (0)
#define RESC(a) do { if (__any((a) < 1.f)) { if (hi == 0) al_l[r32] = (a); asm volatile("s_waitcnt lgkmcnt(0)" ::: "memory"); \
    for (int d = 0; d < 4; ++d) for (int r = 0; r < 16; ++r) o[d][r] *= al_l[crow(r, hi)]; } } while (0)
#define WMASK(P0, P1, j) do { if (WIN) { const int dw = dq0 + (j) * KVBLK - wrow; if (!(dw + 63 <= 128 && dw - 31 >= -128)) wmask(P0, P1, dkl + (j) * KVBLK, hi); } } while (0)
  f32x16 pA0, pA1, pB0, pB1; float mnA, mnB, alA = 1.f, alB = 1.f; bf16x8 pa0, pa1, pa2, pa3; const int NT = ntiles;
  const float acc0 = WIN ? 0.f : sink;
#define PSM(P0, P1, MN, AL) do { if constexpr (WIN) partialSM(P0, P1, m_reg, MN, AL); else partialSM_nomax(P0); } while (0)
#define RESCW(a) do { if constexpr (WIN) RESC(a); } while (0)
  if (wid >= 4) __builtin_amdgcn_s_setprio(1);
  constexpr int SE = 0, SO = SDEPTH - 1;
  if (!preloaded) SLOADP(Kh, Vh);
  asm volatile("s_waitcnt vmcnt(0)" ::: "memory"); SWRITE(0, SE);
  SLOAD(SO, KVBLK); if constexpr (SDEPTH == 2) { if (2 < NT) SLOAD(SE, 2 * KVBLK); }
  __syncthreads();
  qkt(pA0, pA1, K_lds, qr, r32, hi, acc0); WMASK(pA0, pA1, 0); PSM(pA0, pA1, mnA, alA);
  SWAIT(); SWRITE(1, SO); __syncthreads();
  for (int j = 1; j + 1 < NT; j += 2) {
    SBAR(); qkt(pB0, pB1, (bf16*)((char*)K_lds + SHM_K), qr, r32, hi, acc0); WMASK(pB0, pB1, j);
    finishSM(pA0, pA1, alA, l_reg, pa0, pa1, pa2, pa3); SBAR();
    SLOAD(SO, (j + SDEPTH) * KVBLK); SBAR();
    pv_d0(o, vb0, pa0, pa1, pa2, pa3); PSM(pB0, pB1, mnB, alB);
    __syncthreads(); SWAIT(); SWRITE(0, SE);
    RESCW(alB); __syncthreads();
    SBAR(); qkt(pA0, pA1, K_lds, qr, r32, hi, acc0); WMASK(pA0, pA1, j + 1);
    finishSM(pB0, pB1, alB, l_reg, pa0, pa1, pa2, pa3); SBAR();
    if (SDEPTH == 1 || j + 3 < NT) SLOAD(SE, (j + 1 + SDEPTH) * KVBLK); SBAR();
    pv_d0(o, vb0 + (int)SHM_V, pa0, pa1, pa2, pa3); PSM(pA0, pA1, mnA, alA);
    __syncthreads(); SWAIT(); SWRITE(1, SO);
    RESCW(alA); __syncthreads();
  }
  SBAR(); qkt(pB0, pB1, (bf16*)((char*)K_lds + SHM_K), qr, r32, hi, acc0); WMASK(pB0, pB1, NT - 1);
  SBAR();
  if (has_next) { const bf16* Qn = nQb + (long)(wrow + r32) * LDQ + hsel + hi * 8;
#pragma unroll
    for (int d0 = 0; d0 < 8; ++d0) qr[d0] = *reinterpret_cast<const bf16x8*>(Qn + d0 * 16);
    SLOADP(nKh, nVh); }
  SBAR();
  finishSM(pA0, pA1, alA, l_reg, pa0, pa1, pa2, pa3); SBAR();
  pv_d0(o, vb0, pa0, pa1, pa2, pa3); PSM(pB0, pB1, mnB, alB);
  __syncthreads(); RESCW(alB);
  finishSM(pB0, pB1, alB, l_reg, pa0, pa1, pa2, pa3); SBAR();
  pv_d0(o, vb0 + (int)SHM_V, pa0, pa1, pa2, pa3);
  __builtin_amdgcn_s_setprio(0);
  if (hi == 0) li_l[r32] = l_reg; asm volatile("s_waitcnt lgkmcnt(0)" ::: "memory");
  float rli[16];
#pragma unroll
  for (int r = 0; r < 16; ++r) rli[r] = __builtin_amdgcn_rcpf(li_l[crow(r, hi)]);
  __syncthreads();
  unsigned short* stg = (unsigned short*)(lds + wid * 8192);
#pragma unroll
  for (int r = 0; r < 16; ++r) { const int orow = crow(r, hi);
#pragma unroll
    for (int d0 = 0; d0 < 4; ++d0) { const unsigned w = cvtpk(o[d0][r] * rli[r], 0.f); stg[orow * 128 + d0 * 32 + r32] = (unsigned short)w; } }
  asm volatile("s_waitcnt lgkmcnt(0)" ::: "memory");
  bf16* Ow = Ob + (long)wrow * LDO + hsel;
#pragma unroll
  for (int i = 0; i < 8; ++i) { const int idx = i * 64 + lane, row = idx >> 4, c8 = (idx & 15) * 8;
    const u32x4 v = *reinterpret_cast<const u32x4*>(stg + row * 128 + c8);
    *reinterpret_cast<u32x4*>(Ow + (long)row * LDO + c8) = v; }
  __syncthreads();
#undef SLOAD
#undef SLOADP
#undef SWRITE
#undef SWAIT
#undef RESC
#undef WMASK
#undef PSM
#undef RESCW
}
#undef KSWZ
#undef SBAR
}
#ifndef MK_LAUNCH_MODE
#define MK_LAUNCH_MODE 1
#endif
constexpr int NWAVES = 8;
constexpr int DM = 2048, NTOK = 40960, S0 = 8192, S1 = 4096, NBATCH = 9, DEPTH = 4, INW = 7168, DFF = 5632, NMOD = 6 * DM;
constexpr int Z_QA = 0, Z_KA = 1024, Z_VA = 1280, Z_QB = 1536, Z_KB = 2560, Z_VB = 2816, Z_GA = 3072, Z_GB = 5120;
constexpr float EPS = 1e-6f;
constexpr size_t MiB = 1u << 20;
constexpr size_t WS_CTL = 0, CTL_ZERO_BYTES = 1 * MiB;
constexpr size_t WS_MOD = 1 * MiB;
constexpr size_t WS_TAB = 3 * MiB;
constexpr size_t TAB_COS1 = 0, TAB_SIN1 = 8192 * 64, TAB_CR = 2 * 8192 * 64, TAB_SR = TAB_CR + 128 * 32, TAB_CC = TAB_SR + 128 * 32, TAB_SC = TAB_CC + 64 * 32;
constexpr size_t WS_WT = 8 * MiB;
constexpr size_t W_IN = 0, W_BR = W_IN + (size_t)INW * DM, W_OUT = W_BR + (size_t)DM * DM, W_13 = W_OUT + (size_t)DM * DM, W_2 = W_13 + (size_t)2 * DFF * DM, LAYER_W = W_2 + (size_t)DM * DFF;
constexpr size_t WS_U = WS_WT + DEPTH * LAYER_W * 2;
constexpr size_t WS_Z = WS_U + (size_t)NTOK * DM * 2;
constexpr size_t WS_O = WS_Z + (size_t)NTOK * INW * 2;
constexpr size_t WS_MG = WS_U;
constexpr size_t WS_X = WS_O + (size_t)NTOK * DM * 2;
constexpr size_t WS_END = WS_X + (size_t)NTOK * DM * 2;
static_assert(WS_WT % 256 == 0 && WS_U % 256 == 0 && WS_Z % 256 == 0 && WS_O % 256 == 0 && WS_X % 256 == 0, "ws map alignment");
static_assert((size_t)NTOK * DFF * 2 <= (size_t)NTOK * INW * 2, "H overlays Z");
constexpr int CW_TMO = 0, CW_CODE = 1, CW_BAR = 4096;
constexpr int RING_OFF = 0, RING_BYTES = 131072, LDSCTL_OFF = RING_BYTES, MISC_OFF = LDSCTL_OFF + 320, XCH_OFF = LDSCTL_OFF + 1024  , LDS_BYTES = 147456;
static_assert(XCH_OFF + 8192 <= LDS_BYTES, "LDS map");
constexpr int PH_PRO = 0, PH_NORM0 = 1, PH_L0 = 2, PH_PER_LAYER = 8, N_PHASES = PH_L0 + DEPTH * PH_PER_LAYER;

#define GAS __attribute__((address_space(1)))
#define LAS __attribute__((address_space(3)))
typedef unsigned short bf16;
typedef unsigned v4u __attribute__((ext_vector_type(4)));
typedef unsigned v2u __attribute__((ext_vector_type(2)));
typedef float f32x4 __attribute__((ext_vector_type(4)));
typedef GAS unsigned gu32;
#define RLX_AGENT __ATOMIC_RELAXED, __HIP_MEMORY_SCOPE_AGENT
#define LDS_WAIT() asm volatile("s_waitcnt lgkmcnt(0)" ::: "memory")
#define VM_WAIT() asm volatile("s_waitcnt vmcnt(0)" ::: "memory")
__device__ __forceinline__ unsigned f2bf(float f) { unsigned u = __builtin_bit_cast(unsigned, f); return (u + 0x7fffu + ((u >> 16) & 1u)) >> 16; }
__device__ __forceinline__ unsigned pk2(float lo, float hi) { return f2bf(lo) | (f2bf(hi) << 16); }
__device__ __forceinline__ float bflo(unsigned w) { return __uint_as_float(w << 16); }
__device__ __forceinline__ float bfhi(unsigned w) { return __uint_as_float(w & 0xffff0000u); }

#define XB_TMO      128
#define XB_XCNT(j)  (256  + 64 * (j))
#define XB_XSUB(j)  (1280 + 64 * (j))
#define XB_XGEN(j)  (2304 + 64 * (j))
#define XB_TOP      3328
#define XB_TOPGEN   3392
#define XCD_BAR_WORDS 3456
#define XB_SPIN_CAP (1u << 18)

__device__ __forceinline__ unsigned xb_ld(unsigned* p)              { return __hip_atomic_load(p, __ATOMIC_RELAXED, __HIP_MEMORY_SCOPE_AGENT); }
__device__ __forceinline__ unsigned xb_add(unsigned* p, unsigned v) { return __hip_atomic_fetch_add(p, v, __ATOMIC_RELAXED, __HIP_MEMORY_SCOPE_AGENT); }
__device__ __forceinline__ unsigned xb_xcc_id() { return (unsigned)__builtin_amdgcn_s_getreg((3 << 11) | 20) & 0xFu; }
#define XB_SPIN(cond, bar) do { unsigned _sp = 0; while (cond) { __builtin_amdgcn_s_sleep(1); \
    if ((++_sp & 255u) == 0u) { if (xb_ld(&(bar)[XB_TMO])) break; if (_sp > XB_SPIN_CAP) { atomicAdd(&(bar)[XB_TMO], 1u); break; } } } } while (0)

struct XcdBarrier {
    unsigned* bar; unsigned x;
    volatile LAS unsigned* st;
};

__device__ __forceinline__ XcdBarrier xcd_barrier_post(unsigned* bar, volatile LAS unsigned* st) {
    XcdBarrier b; b.bar = bar; b.x = xb_xcc_id(); b.st = st;
    if (threadIdx.x == 0) (void)xb_add(&bar[XB_XCNT(b.x)], 1u);
    return b;
}
__device__ __forceinline__ void xcd_barrier_complete(unsigned* bar, unsigned x, unsigned& nloc, unsigned& nx) {
    const unsigned G = gridDim.x * gridDim.y * gridDim.z;
    unsigned sum, cnt, mine, sp = 0u;
    for (;;) {
        sum = 0u; cnt = 0u; mine = 0u;
#pragma unroll
        for (unsigned j = 0; j < 16; ++j) { const unsigned c = xb_ld(&bar[XB_XCNT(j)]); sum += c; cnt += (c > 0u) ? 1u : 0u; mine = (j == x) ? c : mine; }
        if (sum == G) break;
        __builtin_amdgcn_s_sleep(1);
        if ((++sp & 255u) == 0u) { if (xb_ld(&bar[XB_TMO])) break; if (sp > XB_SPIN_CAP) { atomicAdd(&bar[XB_TMO], 1u); break; } }
    }
    nloc = mine > 0u ? mine : 1u; nx = cnt > 0u ? cnt : 1u;
}

__device__ __forceinline__ void xcd_barrier(const XcdBarrier& b) {
    asm volatile("s_waitcnt vmcnt(0)" ::: "memory");
    __syncthreads();
    if (threadIdx.x == 0) {
        unsigned* bar = b.bar;
        __builtin_amdgcn_s_waitcnt(0);
        unsigned nloc = b.st[0], nx = b.st[1];
        if (nloc == 0u) { xcd_barrier_complete(bar, b.x, nloc, nx); b.st[0] = nloc; b.st[1] = nx; }
        const unsigned old = xb_add(&bar[XB_XSUB(b.x)], 1u);
        const unsigned gen = old / nloc;
        if (old + 1u == (gen + 1u) * nloc) {
            __builtin_amdgcn_fence(__ATOMIC_RELEASE, "agent");
            asm volatile("s_waitcnt vmcnt(0)" ::: "memory");
            const unsigned og = xb_add(&bar[XB_TOP], 1u);
            const unsigned tg = og / nx;
            if (og + 1u == (tg + 1u) * nx) xb_add(&bar[XB_TOPGEN], 1u);
            else XB_SPIN(xb_ld(&bar[XB_TOPGEN]) == tg, bar);
            __builtin_amdgcn_fence(__ATOMIC_ACQUIRE, "agent");
            xb_add(&bar[XB_XGEN(b.x)], 1u);
            asm volatile("s_waitcnt vmcnt(0)" ::: "memory");
        } else {
            XB_SPIN(xb_ld(&bar[XB_XGEN(b.x)]) == gen, bar);
            __builtin_amdgcn_fence(__ATOMIC_ACQUIRE, "agent");
            asm volatile("s_waitcnt vmcnt(0)" ::: "memory");
        }
    }
    __syncthreads();
}


struct Args { const float* in[19]; float* out; unsigned char* ws; int ph_lo, ph_hi, li, pad; };

__device__ __forceinline__ float wave_sum(float v) {
#pragma unroll
    for (int o = 1; o < 64; o <<= 1) v += __shfl_xor(v, o);
    return v;
}
__device__ __forceinline__ int row_batch(int row) { return row < S0 ? 0 : 1 + ((row - S0) >> 12); }
__device__ __forceinline__ int row_pos(int row) { return row < S0 ? row : ((row - S0) & (S1 - 1)); }

__device__ __forceinline__ void sincos_d(double a, float& s, float& c) {
    const double q = __builtin_rint(a * 0.63661977236758134308);
    double r = __builtin_fma(-q, 1.5707963267948966, a); r = __builtin_fma(-q, 6.123233995736766e-17, r);
    const double r2 = r * r;
    double sp = 1.0 / 6227020800.0; sp = sp * r2 - 1.0 / 39916800.0; sp = sp * r2 + 1.0 / 362880.0; sp = sp * r2 - 1.0 / 5040.0; sp = sp * r2 + 1.0 / 120.0; sp = sp * r2 - 1.0 / 6.0; sp = sp * r2 + 1.0; sp = sp * r;
    double cp = -1.0 / 87178291200.0; cp = cp * r2 + 1.0 / 479001600.0; cp = cp * r2 - 1.0 / 3628800.0; cp = cp * r2 + 1.0 / 40320.0; cp = cp * r2 - 1.0 / 720.0; cp = cp * r2 + 1.0 / 24.0; cp = cp * r2 - 0.5; cp = cp * r2 + 1.0;
    const int qi = (int)((long long)q & 3);
    const double ss = (qi & 1) ? cp : sp, cc = (qi & 1) ? sp : cp;
    s = (float)((qi & 2) ? -ss : ss); c = (float)(((qi + 1) & 2) ? -cc : cc);
}
__device__ __forceinline__ float inv_freq(int i, double base) { double v = 1.0; for (int k = 0; k < i; ++k) v *= base; return (float)v; }
__device__ __forceinline__ void p0_tables(float* tab, int gt, int ngt) {
    for (int idx = gt; idx < 8192 * 64; idx += ngt) { const int pos = idx >> 6, i = idx & 63; const float f = inv_freq(i, 0.8659643233600653); const float ang = (float)pos * f;
        float s, c; sincos_d((double)ang, s, c); const int ix = (((pos >> 4) * 16 + (i >> 2)) * 16 + (pos & 15)) * 4 + (i & 3);
        tab[TAB_COS1 + ix] = c; tab[TAB_SIN1 + ix] = s; }
    for (int idx = gt; idx < 128 * 32; idx += ngt) { const int pos = idx >> 5, i = idx & 31; const float f = inv_freq(i, 0.7498942093324558); const float ang = (float)pos * f;
        float s, c; sincos_d((double)ang, s, c); tab[TAB_CR + idx] = c; tab[TAB_SR + idx] = s; if (pos < 64) { const int ix = (((pos >> 4) * 8 + (i >> 2)) * 16 + (pos & 15)) * 4 + (i & 3);
            tab[TAB_CC + ix] = c; tab[TAB_SC + ix] = s; } }
}
__device__ __forceinline__ void p0_mod_item(const float* cp, const float* cs, const float* wmod, const float* bmod, float* mod, LAS float* sc, int item, int tid, int wave, int lane) {
    const int l = item / (NMOD / 256), col0 = (item % (NMOD / 256)) * 256;
    for (int i = tid; i < NBATCH * DM; i += 512) { const float v = (i < DM) ? cp[i] : cs[i - DM]; sc[i] = v * __builtin_amdgcn_rcpf(1.0f + __expf(-v)); }
    __syncthreads();
    f32x4 acc[NBATCH];
#pragma unroll
    for (int b = 0; b < NBATCH; ++b) acc[b] = (f32x4){0.f, 0.f, 0.f, 0.f};
    const float* wp = wmod + (size_t)l * DM * NMOD + (size_t)(wave * 256) * NMOD + col0 + lane * 4;
    for (int k16 = 0; k16 < 16; ++k16) {
        f32x4 w[16];
#pragma unroll
        for (int kk = 0; kk < 16; ++kk) w[kk] = *(const f32x4*)(wp + (size_t)(k16 * 16 + kk) * NMOD);
#pragma unroll
        for (int q = 0; q < 4; ++q)
#pragma unroll
            for (int b = 0; b < NBATCH; ++b) { const f32x4 s4 = *(const LAS f32x4*)(sc + b * DM + wave * 256 + k16 * 16 + q * 4);
                acc[b] += w[4 * q + 0] * s4[0]; acc[b] += w[4 * q + 1] * s4[1]; acc[b] += w[4 * q + 2] * s4[2]; acc[b] += w[4 * q + 3] * s4[3]; }
    }
    __syncthreads();
#pragma unroll
    for (int b = 0; b < NBATCH; ++b) *(LAS f32x4*)(sc + (wave * NBATCH + b) * 256 + lane * 4) = acc[b];
    __syncthreads();
    for (int i = tid; i < NBATCH * 256; i += 512) { const int b = i >> 8, c = i & 255; float s = bmod[(size_t)l * NMOD + col0 + c];
#pragma unroll
        for (int w = 0; w < NWAVES; ++w) s += sc[(w * NBATCH + b) * 256 + c];
        mod[((size_t)l * NBATCH + b) * NMOD + col0 + c] = s; }
    __syncthreads();
}
__device__ __forceinline__ int zperm(int n) {
    if (n >= Z_GA) { const int c = (n - Z_GA) & 2047; return Z_GA + 256 * (c >> 7) + ((n - Z_GA) >> 11) * 128 + (c & 127); }
    const int mode = (n < 1280) ? 1 : (n < 1536) ? 0 : (n < 2816) ? 2 : 0;
    if (mode == 0) return n;
    const int base = n & ~127, e = n & 127;
    if (mode == 1) { const int m = e & 63; return base + 8 * (m >> 2) + 4 * (e >> 6) + (m & 3); }
    const int q = e >> 5, m = e & 31; return base + 8 * ((q >> 1) * 8 + (m >> 2)) + 4 * (q & 1) + (m & 3);
}
constexpr int I_IN = (DM / 64) * (INW / 32), I_BR = (1024 / 64) * (DM / 32), I_OUT = (DM / 64) * (DM / 32), I_13 = (DM / 64) * (2 * DFF / 32), I_2 = (DFF / 64) * (DM / 32);
constexpr int I_LAYER = I_IN + 2 * I_BR + I_OUT + I_13 + I_2;
struct TrItem { const float* src; bf16* dst; int N, ldk, drow0; bool zp; };
template <class AP> __device__ __forceinline__ TrItem tr_decode(AP a, bf16* wt, int it) {
    const int l = it / I_LAYER; int r = it % I_LAYER; bf16* wl = wt + (size_t)l * LAYER_W; TrItem t;
    if (r < I_IN) { const int nb = r % (INW / 32), kb = r / (INW / 32); t.src = a->in[10] + (size_t)l * DM * INW + (size_t)(64 * kb) * INW + 32 * nb; t.N = INW; t.dst = wl + W_IN + 64 * kb; t.ldk = DM; t.drow0 = 32 * nb; t.zp = true; return t; } r -= I_IN;
    if (r < I_BR) { const int nb = r % (DM / 32), kb = r / (DM / 32); t.src = a->in[14] + (size_t)l * 1024 * DM + (size_t)(64 * kb) * DM + 32 * nb; t.N = DM; t.dst = wl + W_BR + 64 * kb; t.ldk = DM; t.drow0 = 32 * nb; t.zp = false; return t; } r -= I_BR;
    if (r < I_BR) { const int nb = r % (DM / 32), kb = r / (DM / 32); t.src = a->in[15] + (size_t)l * 1024 * DM + (size_t)(64 * kb) * DM + 32 * nb; t.N = DM; t.dst = wl + W_BR + 1024 + 64 * kb; t.ldk = DM; t.drow0 = 32 * nb; t.zp = false; return t; } r -= I_BR;
    if (r < I_OUT) { const int nb = r % (DM / 32), kb = r / (DM / 32); t.src = a->in[16] + (size_t)l * DM * DM + (size_t)(64 * kb) * DM + 32 * nb; t.N = DM; t.dst = wl + W_OUT + 64 * kb; t.ldk = DM; t.drow0 = 32 * nb; t.zp = false; return t; } r -= I_OUT;
    if (r < I_13) { const int nb = r % (2 * DFF / 32), kb = r / (2 * DFF / 32); const int n0 = 32 * nb; const int j = n0 < DFF ? n0 : n0 - DFF; const int drow = 256 * (j >> 7) + (n0 < DFF ? 0 : 128) + (j & 127);
        t.src = a->in[17] + (size_t)l * DM * 2 * DFF + (size_t)(64 * kb) * (2 * DFF) + n0; t.N = 2 * DFF; t.dst = wl + W_13 + 64 * kb; t.ldk = DM; t.drow0 = drow; t.zp = false; return t; } r -= I_13;
    { const int nb = r % (DM / 32), kb = r / (DM / 32); t.src = a->in[18] + (size_t)l * DFF * DM + (size_t)(64 * kb) * DM + 32 * nb; t.N = DM; t.dst = wl + W_2 + 64 * kb; t.ldk = DFF; t.drow0 = 32 * nb; t.zp = false; return t; }
}
__device__ __forceinline__ void tr_load(const TrItem& t, float (&wv)[32], int lane) {
#pragma unroll
    for (int i = 0; i < 32; ++i) { const int kk = 2 * i + (lane >> 5); wv[i] = t.src[(size_t)kk * t.N + (lane & 31)]; }
}
__device__ __forceinline__ void tr_store(const TrItem& t, const float (&wv)[32], LAS float* scr, int lane) {
#pragma unroll
    for (int i = 0; i < 32; ++i) { const int kk = 2 * i + (lane >> 5); scr[kk * 33 + (lane & 31)] = wv[i]; }
    LDS_WAIT(); asm volatile("" ::: "memory");
    const int c = lane & 7;
#pragma unroll
    for (int j = 0; j < 4; ++j) { const int n = (lane >> 3) + 8 * j; const LAS float* s = scr + (8 * c) * 33 + n;
        v4u o; o.x = pk2(s[0 * 33], s[1 * 33]); o.y = pk2(s[2 * 33], s[3 * 33]); o.z = pk2(s[4 * 33], s[5 * 33]); o.w = pk2(s[6 * 33], s[7 * 33]);
        const int dr = t.zp ? zperm(t.drow0 + n) : t.drow0 + n;
        *(GAS v4u*)(t.dst + (size_t)dr * t.ldk + 8 * c) = o; }
    LDS_WAIT(); asm volatile("" ::: "memory");
}
template <class AP> __device__ __forceinline__ void p0_transposes(AP a, bf16* wt, LAS float* scr, int it0, int it1, int gw, int ngw, int lane) {
    int it = it0 + gw; if (it >= it1) return;
    float wa[32], wb[32]; TrItem cur = tr_decode(a, wt, it); tr_load(cur, wa, lane);
    for (;;) {
        int nit = it + ngw; TrItem nxt = cur; const bool hn = nit < it1; if (hn) { nxt = tr_decode(a, wt, nit); tr_load(nxt, wb, lane); }
        tr_store(cur, wa, scr, lane); if (!hn) break;
        it = nit + ngw; const bool h2 = it < it1; if (h2) { cur = tr_decode(a, wt, it); tr_load(cur, wa, lane); }
        tr_store(nxt, wb, scr, lane); if (!h2) break;
    }
}

template <int MODE, bool DO_U>
__device__ __forceinline__ void norm_phase(const float* xin, const float* xin2, bf16* xb, float* xout, const bf16* y, bf16* u, const float* g_post, const float* gate, const float* g_pre, const float* scale, const float* shift,
                                           int gw, int ngw, int lane) {
    const int rpw = (NTOK + ngw - 1) / ngw, r0 = gw * rpw, r1 = (r0 + rpw < NTOK) ? r0 + rpw : NTOK;
    f32x4 A[8], Bv[8], Cv[8]; int curb = -1;
    const int cl = 4 * lane, yp = 64 * ((cl >> 5) & 3) + 32 * (cl >> 7) + (cl & 31);
    v2u xw[8], yw[8];
#define NORM_FETCH(row_) do { const bf16* xr_ = xb + (size_t)(row_) * DM + 4 * lane; const bf16* yr_ = y + (size_t)(row_) * DM + yp; \
        _Pragma("unroll") for (int j = 0; j < 8; ++j) xw[j] = *(const v2u*)(xr_ + 256 * j); _Pragma("unroll") for (int j = 0; j < 8; ++j) yw[j] = *(const v2u*)(yr_ + 256 * j); } while (0)
    if (MODE == 1 && r0 < r1) NORM_FETCH(r0);
    for (int row = r0; row < r1; ++row) {
        const int b = row_batch(row);
        if (b != curb) { curb = b; int l4 = 4 * lane; asm volatile("" : "+v"(l4));
#pragma unroll
            for (int j = 0; j < 8; ++j) { const int c = 256 * j + l4;
                if (MODE == 1) A[j] = *(const f32x4*)(gate + (size_t)b * NMOD + c) * *(const f32x4*)(g_post + c);
                if (DO_U) { Bv[j] = *(const f32x4*)(g_pre + c) * (*(const f32x4*)(scale + (size_t)b * NMOD + c) + 1.0f); Cv[j] = *(const f32x4*)(shift + (size_t)b * NMOD + c); } } }
        f32x4 x[8];
        if (MODE == 0) { const float* xr = (row < S0 ? xin + (size_t)row * DM : xin2 + (size_t)(row - S0) * DM) + 4 * lane;
#pragma unroll
            for (int j = 0; j < 8; ++j) x[j] = *(const f32x4*)(xr + 256 * j); }
        else {
            float ss = 0.f;
#pragma unroll
            for (int j = 0; j < 8; ++j) { const v2u w = xw[j]; x[j] = (f32x4){bflo(w.x), bfhi(w.x), bflo(w.y), bfhi(w.y)}; }
#pragma unroll
            for (int j = 0; j < 8; ++j) { const v2u w = yw[j]; const f32x4 yv = (f32x4){bflo(w.x), bfhi(w.x), bflo(w.y), bfhi(w.y)}; ss += (yv[0] * yv[0] + yv[1] * yv[1]) + (yv[2] * yv[2] + yv[3] * yv[3]); }
            const float rstd = __builtin_amdgcn_rsqf(wave_sum(ss) * (1.0f / DM) + EPS);
#pragma unroll
            for (int j = 0; j < 8; ++j) { const v2u w = yw[j]; const f32x4 yv = (f32x4){bflo(w.x), bfhi(w.x), bflo(w.y), bfhi(w.y)}; x[j] += A[j] * (yv * rstd); }
            if (row + 1 < r1) NORM_FETCH(row + 1);
        }
        if (DO_U) {
            bf16* xo = xb + (size_t)row * DM + 4 * lane; float ss = 0.f;
#pragma unroll
            for (int j = 0; j < 8; ++j) { v2u w; w.x = pk2(x[j][0], x[j][1]); w.y = pk2(x[j][2], x[j][3]); *(v2u*)(xo + 256 * j) = w; ss += (x[j][0] * x[j][0] + x[j][1] * x[j][1]) + (x[j][2] * x[j][2] + x[j][3] * x[j][3]); }
            const float rstd = __builtin_amdgcn_rsqf(wave_sum(ss) * (1.0f / DM) + EPS);
            bf16* ur = u + (size_t)row * DM + 4 * lane;
#pragma unroll
            for (int j = 0; j < 8; ++j) { const f32x4 v = x[j] * rstd * Bv[j] + Cv[j]; v2u w; w.x = pk2(v[0], v[1]); w.y = pk2(v[2], v[3]); *(v2u*)(ur + 256 * j) = w; }
        } else {
            float* xo = xout + (size_t)row * DM + 4 * lane;
#pragma unroll
            for (int j = 0; j < 8; ++j) *(f32x4*)(xo + 256 * j) = x[j];
        }
    }
#undef NORM_FETCH
}

__device__ __forceinline__ void attn_phase(const bf16* z, bf16* oab, const float* sink, const float* qn, const float* kn, char* lds, int c, int G) {
    const int x = c & 7, jj = c >> 3, per = (G - x + 7) >> 3;
    float nacc0;
    { const int ln = threadIdx.x & 63; float gq = fmaxf(fabsf(qn[ln]), fabsf(qn[ln + 64])), gk = fmaxf(fabsf(kn[ln]), fabsf(kn[ln + 64]));
#pragma unroll
      for (int o = 1; o < 64; o <<= 1) { gq = fmaxf(gq, __shfl_xor(gq, o)); gk = fmaxf(gk, __shfl_xor(gk, o)); }
      const float bnd = 1.01f * 128.0f * 0.12751743082459868f * gq * gk; nacc0 = -fmaxf(bnd - 40.0f, 0.0f); }
#ifndef MK_REPEAT_ATT
#define MK_REPEAT_ATT 0
#endif
    att::Carry cy;
    for (int rep = 0; rep < ((MK_REPEAT_ATT & 1) ? 2 : 1); ++rep) { bool pre = false;
    for (int T = jj; T < 160; T += per) { const bool pr = T < 32; const int w = T - 32, h = pr ? x : (w >> 4), qb = pr ? T : (w & 15); const size_t r0 = pr ? 0 : S0 + (size_t)x * S1;
        const int Tn = T + per; const bool hn = Tn < 160; const bool prn = Tn < 32; const int wn = Tn - 32, hnx = prn ? x : (wn >> 4), qbn = prn ? Tn : (wn & 15); const size_t r0n = prn ? 0 : S0 + (size_t)x * S1;
        att::attn_body<false, 1>(z + (r0 + 256 * qb) * INW + Z_QB + h * 128, z + r0 * INW + Z_KB + (h >> 2) * 128, z + r0 * INW + Z_VB + (h >> 2) * 128,
                                 oab + (r0 + 256 * qb) * DM + 1024 + h * 128, pr ? S0 / 64 : S1 / 64, 0, nacc0, 0.f, lds,
                                 cy, pre, z + (r0n + 256 * qbn) * INW + Z_QB + hnx * 128, z + r0n * INW + Z_KB + (hnx >> 2) * 128, z + r0n * INW + Z_VB + (hnx >> 2) * 128, hn);
        pre = hn; } }
    { bool pre = false;
    for (int LL = jj; LL < 160; LL += per) {
#define WIN_UNIT(L_, row0_, h_, s0_, klo_, khi_) const int pm##L_ = ((L_) >> 3) * 8 + x, row0_ = 256 * pm##L_ + 128 * (((L_) >> 2) & 1), h_ = 2 * ((L_) & 3); \
        const int s0_ = row0_ < S0 ? 0 : S0 + ((row0_ - S0) & ~(S1 - 1)), S##L_ = row0_ < S0 ? S0 : S1, i0##L_ = row0_ - s0_; \
        const int klo_ = i0##L_ - 128 < 0 ? 0 : i0##L_ - 128, khi_ = i0##L_ + 256 > S##L_ ? S##L_ : i0##L_ + 256
        WIN_UNIT(LL, row0, h, s0, klo, khi); const int Ln = LL + per; const bool hn = Ln < 160; WIN_UNIT(Ln, row0n, hnx, s0n, klon, khin); (void)khin;
        att::attn_body<true, 1>(z + (size_t)row0 * INW + Z_QA + h * 128, z + (size_t)(s0 + klo) * INW + Z_KA + (h >> 2) * 128, z + (size_t)(s0 + klo) * INW + Z_VA + (h >> 2) * 128,
                                oab + (size_t)row0 * DM + h * 128, (khi - klo) / 64, klo - (row0 - s0), sink[h], sink[h + 1], lds,
                                cy, pre, z + (size_t)row0n * INW + Z_QA + hnx * 128, z + (size_t)(s0n + klon) * INW + Z_KA + (hnx >> 2) * 128, z + (size_t)(s0n + klon) * INW + Z_VA + (hnx >> 2) * 128, hn);
        pre = hn; }
#undef WIN_UNIT
    }
}

__device__ __forceinline__ void phase_skew(int bx, unsigned ticks) {
    const unsigned long long want = (unsigned long long)(((unsigned)bx >> 3) & 7u) * ticks, t0 = __builtin_amdgcn_s_memrealtime();
    while (__builtin_amdgcn_s_memrealtime() - t0 < want) __builtin_amdgcn_s_sleep(2);
}
#ifndef MK_SKEW
#define MK_SKEW 0
#endif
typedef const __attribute__((address_space(4))) Args* KArgs;
__device__ __forceinline__ KArgs kargs() { KArgs p = (KArgs)__builtin_amdgcn_kernarg_segment_ptr(); asm volatile("" : "+s"(p)); return p; }
#ifndef MK_KIND_MASK
#define MK_KIND_MASK 0x7ff
#endif
#define KIND(n) ((MK_KIND_MASK >> (n)) & 1)
#ifndef MK_REPEAT_MASK
#define MK_REPEAT_MASK 0
#endif
#define NREP(n) (((MK_REPEAT_MASK >> (n)) & 1) ? 2 : 1)
__global__ void __launch_bounds__(NWAVES * 64, 2) mk_fwd(Args args_unused) {
    extern __shared__ __attribute__((aligned(16))) unsigned char lds[];
    LAS unsigned char* L = (LAS unsigned char*)lds;
    volatile LAS unsigned* MISC = (volatile LAS unsigned*)(L + MISC_OFF);
    const int G = gridDim.x, bx = blockIdx.x, ngw = G * NWAVES;
#define PHASE_IDS int tid = threadIdx.x; asm volatile("" : "+v"(tid)); const int lane = tid & 63, wave = __builtin_amdgcn_readfirstlane(tid >> 6), gw = bx * NWAVES + wave; (void)lane; (void)gw
    for (int u = threadIdx.x; u < (LDS_BYTES - LDSCTL_OFF) / 4; u += NWAVES * 64) ((LAS unsigned*)(L + LDSCTL_OFF))[u] = 0u;
    __syncthreads();
    int lo, hi; XcdBarrier bar;
    { KArgs ap = kargs(); lo = ap->ph_lo; hi = ap->ph_hi; unsigned* bw = (unsigned*)(ap->ws + WS_CTL) + CW_BAR + ap->li * XCD_BAR_WORDS;
      bar.bar = bw; bar.x = 0; bar.st = nullptr; if (hi - lo > 1) bar = xcd_barrier_post(bw, MISC + 8); }
#define IN(k) (lo <= (k) && (k) < hi)
#define SEAM(k) do { if ((k) + 1 < hi) xcd_barrier(bar); } while (0)
#define WSP(T, off) ((T*)(ap->ws + (off)))

    if (KIND(0) && IN(PH_PRO)) {
        KArgs ap = kargs(); PHASE_IDS;
            for (int rep = 0; rep < NREP(0); ++rep) {
        p0_tables(WSP(float, WS_TAB), bx * 512 + tid, G * 512);
        for (int it = bx; it < DEPTH * (NMOD / 256); it += G) p0_mod_item(ap->in[2], ap->in[3], ap->in[8], ap->in[9], WSP(float, WS_MOD), (LAS float*)(L + RING_OFF), it, tid, wave, lane);
        p0_transposes(ap, WSP(bf16, WS_WT), (LAS float*)(L + RING_OFF + wave * 16384), 0, DEPTH * I_LAYER, gw, ngw, lane);
            }
        SEAM(PH_PRO);
    }
    if (KIND(1) && IN(PH_NORM0)) {
        KArgs ap = kargs(); PHASE_IDS; const float* mod = WSP(float, WS_MOD);
        norm_phase<0, true>(ap->in[0], ap->in[1], WSP(bf16, WS_X), nullptr, nullptr, WSP(bf16, WS_U), nullptr, nullptr, ap->in[4], mod + 1 * DM, mod + 0 * DM, gw, ngw, lane);
        SEAM(PH_NORM0);
    }
    for (int l = 0; l < DEPTH; ++l) {
        const int pb = PH_L0 + PH_PER_LAYER * l;
        if (KIND(2) && IN(pb + 0)) {
            KArgs ap = kargs(); PHASE_IDS;
            for (int rep = 0; rep < NREP(2); ++rep) {
            pg8::Gemm g{WSP(bf16, WS_U), WSP(bf16, WS_WT) + (size_t)l * LAYER_W + W_IN, NTOK, INW, DM}; pg8::StaticOrder S; S.init(NTOK, INW, G, bx); S.split_tail();
            pg8::EpiZ E{WSP(bf16, WS_Z), INW, WSP(float, WS_TAB), ap->in[11] + l * 128, ap->in[12] + l * 128, (LAS float*)(L + XCH_OFF)};
            static_assert(pg8::EpiZ::tab_cos1 == TAB_COS1 && pg8::EpiZ::tab_sin1 == TAB_SIN1 && pg8::EpiZ::tab_cr == TAB_CR && pg8::EpiZ::tab_sr == TAB_SR && pg8::EpiZ::tab_cc == TAB_CC && pg8::EpiZ::tab_sc == TAB_SC, "table offsets");
            pg8::gemm_phase<pg8::EpiZ, pg8::StaticOrder, true, true>(L + RING_OFF, g, S, E);
            { pg8::TailOrder T{S}; pg8::gemm_phase<pg8::EpiZ, pg8::TailOrder, true, true, false, true>(L + RING_OFF, g, T, E); }
            }
            SEAM(pb + 0);
        }
        if (KIND(4) && IN(pb + 1)) {
            KArgs ap = kargs(); PHASE_IDS;
            for (int rep = 0; rep < NREP(4); ++rep) {
            attn_phase(WSP(bf16, WS_Z), WSP(bf16, WS_O), ap->in[13] + l * 8, ap->in[11] + l * 128, ap->in[12] + l * 128, (char*)lds + RING_OFF, bx, G);
            }
            SEAM(pb + 1);
        }
        if (KIND(5) && IN(pb + 2)) {
            KArgs ap = kargs(); PHASE_IDS;
            for (int rep = 0; rep < NREP(5); ++rep) {
            pg8::Gemm g{WSP(bf16, WS_O), WSP(bf16, WS_WT) + (size_t)l * LAYER_W + W_BR, NTOK, DM, DM}; pg8::StaticOrder S; S.init(NTOK, DM, G, bx);
            pg8::EpiMerge E{WSP(bf16, WS_MG), DM, 1024 / pg8::BK, WSP(bf16, WS_Z), INW, Z_GA, Z_GB};
            pg8::gemm_phase<pg8::EpiMerge, pg8::StaticOrder, true, true>(L + RING_OFF, g, S, E);
            }
            SEAM(pb + 2);
        }
        if (KIND(6) && IN(pb + 3)) {
            KArgs ap = kargs(); PHASE_IDS;
            for (int rep = 0; rep < NREP(6); ++rep) {
            pg8::Gemm g{WSP(bf16, WS_MG), WSP(bf16, WS_WT) + (size_t)l * LAYER_W + W_OUT, NTOK, DM, DM}; pg8::StaticOrder S; S.init(NTOK, DM, G, bx);
            pg8::EpiPlain E{WSP(bf16, WS_O), DM};
            pg8::gemm_phase<pg8::EpiPlain, pg8::StaticOrder, true, true>(L + RING_OFF, g, S, E);
            }
            SEAM(pb + 3);
        }
        if (KIND(7) && IN(pb + 4)) {
            KArgs ap = kargs(); PHASE_IDS; const float* modl = WSP(float, WS_MOD) + (size_t)l * NBATCH * NMOD;
            norm_phase<1, true>(nullptr, nullptr, WSP(bf16, WS_X), nullptr, WSP(bf16, WS_O), WSP(bf16, WS_U), ap->in[5] + l * DM, modl + 2 * DM, ap->in[6] + l * DM, modl + 4 * DM, modl + 3 * DM, gw, ngw, lane);
            SEAM(pb + 4);
        }
        if (KIND(8) && IN(pb + 5)) {
            KArgs ap = kargs(); PHASE_IDS;
            for (int rep = 0; rep < NREP(8); ++rep) {
            pg8::Gemm g{WSP(bf16, WS_U), WSP(bf16, WS_WT) + (size_t)l * LAYER_W + W_13, NTOK, 2 * DFF, DM}; pg8::StaticOrder S; S.init(NTOK, 2 * DFF, G, bx); S.split_tail();
            pg8::EpiSwiglu E{WSP(bf16, WS_Z), DFF};
            pg8::gemm_phase<pg8::EpiSwiglu, pg8::StaticOrder, true, true>(L + RING_OFF, g, S, E);
            { pg8::TailOrder T{S}; pg8::gemm_phase<pg8::EpiSwiglu, pg8::TailOrder, true, true, false, true>(L + RING_OFF, g, T, E); }
            }
            SEAM(pb + 5);
        }
        if (KIND(9) && IN(pb + 6)) {
            KArgs ap = kargs(); PHASE_IDS;
            for (int rep = 0; rep < NREP(9); ++rep) {
            pg8::Gemm g{WSP(bf16, WS_Z), WSP(bf16, WS_WT) + (size_t)l * LAYER_W + W_2, NTOK, DM, DFF}; pg8::StaticOrder S; S.init(NTOK, DM, G, bx);
            pg8::EpiPlain E{WSP(bf16, WS_O), DM};
            pg8::gemm_phase<pg8::EpiPlain, pg8::StaticOrder, true, true, true>(L + RING_OFF, g, S, E);
            }
            SEAM(pb + 6);
        }
        if (KIND(10) && IN(pb + 7)) {
            KArgs ap = kargs(); PHASE_IDS; const float* modl = WSP(float, WS_MOD) + (size_t)l * NBATCH * NMOD;
            if (l + 1 < DEPTH) { const float* modn = modl + (size_t)NBATCH * NMOD;
                norm_phase<1, true>(nullptr, nullptr, WSP(bf16, WS_X), nullptr, WSP(bf16, WS_O), WSP(bf16, WS_U), ap->in[7] + l * DM, modl + 5 * DM, ap->in[4] + (l + 1) * DM, modn + 1 * DM, modn + 0 * DM, gw, ngw, lane); }
            else norm_phase<1, false>(nullptr, nullptr, WSP(bf16, WS_X), ap->out, WSP(bf16, WS_O), nullptr, ap->in[7] + l * DM, modl + 5 * DM, nullptr, nullptr, nullptr, gw, ngw, lane);
            SEAM(pb + 7);
        }
    }
#undef IN
#undef SEAM
#undef WSP
#undef PHASE_IDS
}

extern "C" void kernel_launch(void* const* d_in, const int* in_sizes, int n_in, void* d_out, int out_size, void* d_ws, size_t ws_size, hipStream_t stream) {
    static int grid = 0;
    if (grid == 0) {
        if (n_in != 19 || out_size != NTOK * DM || ws_size < WS_END) { fprintf(stderr, "kernel_launch: unexpected shapes (n_in %d out %d ws %zu, need ws >= %zu); nothing launched\n", n_in, out_size, ws_size, (size_t)WS_END); grid = -1; return; }
        int dev = 0, cus = 0, per_cu = 0;
        if (hipGetDevice(&dev) != hipSuccess || hipDeviceGetAttribute(&cus, hipDeviceAttributeMultiprocessorCount, dev) != hipSuccess) { grid = -1; return; }
        if (hipFuncSetAttribute((const void*)mk_fwd, hipFuncAttributeMaxDynamicSharedMemorySize, LDS_BYTES) != hipSuccess) { fprintf(stderr, "kernel_launch: hipFuncSetAttribute failed\n"); grid = -1; return; }
        if (hipOccupancyMaxActiveBlocksPerMultiprocessor(&per_cu, (const void*)mk_fwd, NWAVES * 64, LDS_BYTES) != hipSuccess || per_cu < 1) { fprintf(stderr, "kernel_launch: occupancy query says %d blocks per CU\n", per_cu); }
        (void)hipGetLastError();
        grid = cus;
    }
    if (grid < 0) return;
    if (hipMemsetAsync((char*)d_ws + WS_CTL, 0, CTL_ZERO_BYTES, stream) != hipSuccess) return;
    Args a{};
    for (int i = 0; i < 19; ++i) a.in[i] = (const float*)d_in[i];
    a.out = (float*)d_out; a.ws = (unsigned char*)d_ws;
#if MK_LAUNCH_MODE == 1
    a.ph_lo = 0; a.ph_hi = N_PHASES; a.li = 0; a.pad = 0;
    hipLaunchKernelGGL(mk_fwd, dim3(grid), dim3(NWAVES * 64), LDS_BYTES, stream, a);
#else
    for (int p = 0; p < N_PHASES; ++p) { a.ph_lo = p; a.ph_hi = p + 1; a.li = 0; a.pad = 0;
        hipLaunchKernelGGL(mk_fwd, dim3(grid), dim3(NWAVES * 64), LDS_BYTES, stream, a); }
#endif
    const hipError_t le = hipPeekAtLastError();
    if (le != hipSuccess) fprintf(stderr, "kernel_launch: launch failed: %s\n", hipGetErrorName(le));
}
```

```cpp
#include <hip/hip_runtime.h>
#include <cstdio>
#include <cstdint>
namespace pg8 {
#define PG8_LAS __attribute__((address_space(3)))
typedef unsigned short bf16_t;
typedef short bf16x8 __attribute__((ext_vector_type(8)));
typedef float f32x4 __attribute__((ext_vector_type(4)));
typedef unsigned u32x4 __attribute__((ext_vector_type(4)));
constexpr int BM = 256, BK = 64, HALF = 128, HTB = HALF * BK * 2  , STAGE_BYTES = 8 * HTB, NXCD = 8, WGM = 4;

__host__ __device__ __forceinline__ int lds_byte(int r, int c) { const int st = (r >> 4) * 2 + (c >> 5), rr = r & 15, cc = c & 31, ob = rr * 64 + cc * 2; return st * 1024 + (ob ^ (((ob >> 9) & 1) << 5)); }
__host__ __device__ __forceinline__ void stage_rc(int b, int& R, int& C) { const int st = b / 1024, sb = b % 1024, swz = sb ^ (((sb >> 9) & 1) << 5); R = (st >> 1) * 16 + swz / 64; C = (st & 1) * 32 + (swz % 64) / 2; }
__host__ __device__ __forceinline__ int perm32(int rho) { const int n = rho >> 4, i = rho & 15; return 8 * (i >> 2) + 4 * n + (i & 3); }

struct Unit { int pm, pn, hf; };
struct Gemm { const bf16_t* A; const bf16_t* Bt; int M, N, K; };

struct StaticOrder {
    int nM, nN, nwg, G, c, lim;
    __host__ __device__ void init(int M, int N, int G_, int c_) { nM = M / BM; nN = N / BM; nwg = nM * nN; G = G_; c = c_; lim = nwg; }
    __host__ __device__ void split_tail() { const int full = (nwg / G) * G; if (2 * (nwg - full) <= G) lim = full; }
    __host__ __device__ void map(int wgid, Unit& u) const {
        { const int q = nwg / NXCD, r = nwg % NXCD, xcd = wgid % NXCD, off = wgid / NXCD; wgid = (xcd < r ? xcd * (q + 1) : r * (q + 1) + (xcd - r) * q) + off; }
        const int nig = WGM * nN, gid = wgid / nig, fm = gid * WGM, gsz = (nM - fm) < WGM ? (nM - fm) : WGM;
        u.pm = fm + ((wgid % nig) % gsz); u.pn = (wgid % nig) / gsz; u.hf = 0;
    }
    __host__ __device__ bool next(int i, Unit& u) const { const long L = (long)i * G + c; if (L >= lim) return false; map((int)L, u); return true; }
    __device__ __forceinline__ void a_ready(const Unit&) const {}
    __device__ __forceinline__ void done(const Unit&) const {}
};
struct TailOrder {
    StaticOrder S;
    __host__ __device__ bool next(int i, Unit& u) const { const int L = S.lim + (S.c >> 1); if (i > 0 || L >= S.nwg) return false; S.map(L, u); u.hf = S.c & 1; return true; }
    __device__ __forceinline__ void a_ready(const Unit&) const {}
    __device__ __forceinline__ void done(const Unit&) const {}
};
typedef float f32x2_t __attribute__((ext_vector_type(2))); typedef __bf16 bf16x2_t __attribute__((ext_vector_type(2)));
__device__ __forceinline__ unsigned cvt_pk_bf16(float lo, float hi) { f32x2_t v = {lo, hi}; bf16x2_t b = __builtin_convertvector(v, bf16x2_t); return __builtin_bit_cast(unsigned, b); }
typedef float f32x2 __attribute__((ext_vector_type(2)));
typedef unsigned u32x2 __attribute__((ext_vector_type(2)));
__device__ __forceinline__ float bf_lo(unsigned w) { return __uint_as_float(w << 16); }
__device__ __forceinline__ float bf_hi(unsigned w) { return __uint_as_float(w & 0xffff0000u); }
__device__ __forceinline__ float sigmoid_f(float x) { return __builtin_amdgcn_rcpf(1.0f + __builtin_amdgcn_exp2f(x * -1.4426950408889634f)); }
__device__ __forceinline__ u32x4 pack8(const f32x4 v0, const f32x4 v1) { u32x4 w; w.x = cvt_pk_bf16(v0[0], v0[1]); w.y = cvt_pk_bf16(v0[2], v0[3]); w.z = cvt_pk_bf16(v1[0], v1[1]); w.w = cvt_pk_bf16(v1[2], v1[3]); return w; }
__device__ __forceinline__ void unpack8(const u32x4 w, f32x4& v0, f32x4& v1) { v0 = (f32x4){bf_lo(w.x), bf_hi(w.x), bf_lo(w.y), bf_hi(w.y)}; v1 = (f32x4){bf_lo(w.z), bf_hi(w.z), bf_lo(w.w), bf_hi(w.w)}; }

template <bool NT> __device__ __forceinline__ void st16(bf16_t* p, const u32x4 v) { if (NT) __builtin_nontemporal_store(v, (u32x4*)p); else *(u32x4*)p = v; }
__device__ __forceinline__ unsigned dpp_ror8(unsigned v) { return (unsigned)__builtin_amdgcn_update_dpp(0, (int)v, 0x128  , 0xf, 0xf, false); }
struct EpiPlain {
    static constexpr bool PERM = true, AFTER_DRAIN = false, HAS_MID = false;
    bf16_t* O; int ldc;
    __device__ __forceinline__ void operator()(const f32x4 (&acc)[2][2][4][2], const Unit& u, int wr, int wc, int fr, int fq) const {
        const bool low = fr < 8;
        const int row0 = u.pm * BM + wr * 64 + (fr & 7), colp = u.pn * BM + wc * 64 + (low ? 0 : 32) + 8 * fq;
#pragma unroll
        for (int ai = 0; ai < 2; ++ai)
#pragma unroll
            for (int m = 0; m < 4; ++m) { bf16_t* rowp = O + (size_t)(row0 + ai * HALF + m * 16) * ldc + colp;
                const u32x4 X = pack8(acc[ai][0][m][0], acc[ai][0][m][1]), Y = pack8(acc[ai][1][m][0], acc[ai][1][m][1]);
                u32x4 S = low ? Y : X, R; R.x = dpp_ror8(S.x); R.y = dpp_ror8(S.y); R.z = dpp_ror8(S.z); R.w = dpp_ror8(S.w);
                *(u32x4*)rowp = low ? X : R;
                *(u32x4*)(rowp + (size_t)8 * ldc) = low ? R : Y; }
    }
};
#ifndef MK_NT_Z
#define MK_NT_Z false
#endif
struct EpiZ {
    static constexpr bool PERM = true, AFTER_DRAIN = false, HAS_MID = false;
    bf16_t* O; int ldc; const float* tab; const float* qn; const float* kn; PG8_LAS float* P;
    static constexpr int tab_cos1 = 0, tab_sin1 = 8192 * 64, tab_cr = 2 * 8192 * 64, tab_sr = tab_cr + 128 * 32, tab_cc = tab_sr + 128 * 32, tab_sc = tab_cc + 64 * 32;
    __device__ __forceinline__ void operator()(const f32x4 (&acc)[2][2][4][2], const Unit& u, int wr, int wc, int fr, int fq) const { body<2>(acc, u, 0, wr, wc, fr, fq); }
    __device__ __forceinline__ void half(const f32x4 (&acc)[2][2][4][2], const Unit& u, int wr, int wc, int fr, int fq) const { body<1>(acc, u, u.hf * HALF, wr, wc, fr, fq); }
    template <int NAI> __device__ __forceinline__ void body(const f32x4 (&acc)[2][2][4][2], const Unit& u, const int rofs, int wr, int wc, int fr, int fq) const {
        asm volatile("" : "+v"(fr), "+v"(fq));
        const int row0 = u.pm * BM + rofs + wr * 64 + fr, col0 = u.pn * BM + wc * 32 + 8 * fq;
        const int kind = (u.pn <= 4) ? 1 : ((u.pn >= 6 && u.pn <= 10) ? 2 : 0);
        if (kind == 0) {
            if (u.pn >= 12) {
                const int cg = (u.pn - 12) * 4 + wc;
                const size_t gbase = (size_t)((u.pm * 16 + (rofs >> 4) + wr * 4) * 16 + (cg >> 3)) * ldc + 3072 + (cg & 7) * 512 + (fq * 16 + fr) * 8;
#pragma unroll
                for (int ai = 0; ai < NAI; ++ai)
#pragma unroll
                    for (int m = 0; m < 4; ++m) { bf16_t* rowp = O + gbase + (size_t)((ai * 8 + m) * 16) * ldc;
                        f32x4 r0, r1, s0, s1;
#pragma unroll
                        for (int j = 0; j < 4; ++j) {
                            const float ea0 = __builtin_amdgcn_exp2f(__builtin_amdgcn_fmed3f(acc[ai][0][m][0][j] * -1.4426950408889634f, -60.f, 60.f)), ea1 = __builtin_amdgcn_exp2f(__builtin_amdgcn_fmed3f(acc[ai][0][m][1][j] * -1.4426950408889634f, -60.f, 60.f));
                            const float eb0 = __builtin_amdgcn_exp2f(__builtin_amdgcn_fmed3f(acc[ai][1][m][0][j] * -1.4426950408889634f, -60.f, 60.f)), eb1 = __builtin_amdgcn_exp2f(__builtin_amdgcn_fmed3f(acc[ai][1][m][1][j] * -1.4426950408889634f, -60.f, 60.f));
                            r0[j] = (1.0f + eb0) * __builtin_amdgcn_rcpf(1.0f + ea0); r1[j] = (1.0f + eb1) * __builtin_amdgcn_rcpf(1.0f + ea1);
                            s0[j] = __builtin_amdgcn_rcpf(1.0f + eb0); s1[j] = __builtin_amdgcn_rcpf(1.0f + eb1); }
                        st16<MK_NT_Z>(rowp, pack8(r0, r1)); st16<MK_NT_Z>(rowp + (size_t)8 * ldc, pack8(s0, s1)); }
                return;
            }
#pragma unroll
            for (int ai = 0; ai < NAI; ++ai)
#pragma unroll
                for (int m = 0; m < 4; ++m) { bf16_t* rowp = O + (size_t)(row0 + ai * HALF + m * 16) * ldc + col0;
#pragma unroll
                    for (int bj = 0; bj < 2; ++bj) st16<MK_NT_Z>(rowp + bj * HALF, pack8(acc[ai][bj][m][0], acc[ai][bj][m][1])); }
            return;
        }
        const int g = 4 * wc + fq;
        const int prow0 = u.pm * BM;
        const int pos0 = (prow0 < 8192 ? prow0 : ((prow0 - 8192) & 4095)) + rofs + wr * 64 + fr;
        if (kind == 1) {
            f32x4 cc[2][4], sn[2][4];
#pragma unroll
            for (int ai = 0; ai < NAI; ++ai)
#pragma unroll
                for (int m = 0; m < 4; ++m) { const int pos = pos0 + ai * HALF + m * 16; const int ix = (((pos >> 4) * 16 + g) * 16 + (pos & 15)) * 4; cc[ai][m] = *(const f32x4*)(tab + tab_cos1 + ix); sn[ai][m] = *(const f32x4*)(tab + tab_sin1 + ix); }
#pragma unroll
            for (int ai = 0; ai < NAI; ++ai)
#pragma unroll
                for (int m = 0; m < 4; ++m) { bf16_t* rowp = O + (size_t)(row0 + ai * HALF + m * 16) * ldc + col0; const f32x4 c = cc[ai][m], s = sn[ai][m];
#pragma unroll
                    for (int bj = 0; bj < 2; ++bj) { const f32x4 v0 = acc[ai][bj][m][0], v1 = acc[ai][bj][m][1];
                        st16<MK_NT_Z>(rowp + bj * HALF, pack8(v0 * c - v1 * s, v1 * c + v0 * s)); } }
            return;
        }
        float ss[2][4][2];
#pragma unroll
        for (int ai = 0; ai < NAI; ++ai)
#pragma unroll
            for (int m = 0; m < 4; ++m)
#pragma unroll
                for (int bj = 0; bj < 2; ++bj) { const f32x4 a = acc[ai][bj][m][0], b = acc[ai][bj][m][1];
                    float t = (a[0] * a[0] + a[1] * a[1]) + (a[2] * a[2] + a[3] * a[3]) + (b[0] * b[0] + b[1] * b[1]) + (b[2] * b[2] + b[3] * b[3]);
                    t += __shfl_xor(t, 16); t += __shfl_xor(t, 32); ss[ai][m][bj] = t;
                    if (fq == 0) P[((ai * HALF + wr * 64 + m * 16 + fr) * 2 + bj) * 4 + wc] = t; }
        asm volatile("s_waitcnt lgkmcnt(0)" ::: "memory"); __builtin_amdgcn_s_barrier(); asm volatile("" ::: "memory");
        const float* gn = (u.pn == 10) ? kn : qn; const float kmul = (u.pn == 10) ? 0.12751743082459868f : 1.0f;
        const int gg = g & 7, n0 = (g < 8) ? 4 * g : 64 + 4 * gg;
        const f32x4 g0 = *(const f32x4*)(gn + n0), g1 = *(const f32x4*)(gn + n0 + 32);
#pragma unroll
        for (int ai = 0; ai < NAI; ++ai)
#pragma unroll
            for (int m = 0; m < 4; ++m) { const int pos = pos0 + ai * HALF + m * 16; bf16_t* rowp = O + (size_t)(row0 + ai * HALF + m * 16) * ldc + col0;
                const int toff = (g < 8) ? (pos >> 6) * 32 + 4 * gg : ((((pos & 63) >> 4) * 8 + gg) * 16 + (pos & 15)) * 4;
                const f32x4 c = *(const f32x4*)(tab + ((g < 8) ? tab_cr : tab_cc) + toff), s = *(const f32x4*)(tab + ((g < 8) ? tab_sr : tab_sc) + toff);
#pragma unroll
                for (int bj = 0; bj < 2; ++bj) { const f32x4 pp = *(const PG8_LAS f32x4*)(P + ((ai * HALF + wr * 64 + m * 16 + fr) * 2 + bj) * 4);
                    const float rstd = __builtin_amdgcn_rsqf(((pp[0] + pp[1]) + (pp[2] + pp[3])) * (1.0f / 128.0f) + 1e-6f) * kmul;
                    const f32x4 v0 = acc[ai][bj][m][0] * g0 * rstd, v1 = acc[ai][bj][m][1] * g1 * rstd;
                    st16<MK_NT_Z>(rowp + bj * HALF, pack8(v0 * c - v1 * s, v1 * c + v0 * s)); } }
    }
};
struct EpiSwiglu {
    static constexpr bool PERM = true, AFTER_DRAIN = false, HAS_MID = false;
    bf16_t* O; int ldc;
    __device__ __forceinline__ void operator()(const f32x4 (&acc)[2][2][4][2], const Unit& u, int wr, int wc, int fr, int fq) const { body<2>(acc, u, 0, wr, wc, fr, fq); }
    __device__ __forceinline__ void half(const f32x4 (&acc)[2][2][4][2], const Unit& u, int wr, int wc, int fr, int fq) const { body<1>(acc, u, u.hf * 8, wr, wc, fr, fq); }
    template <int NAI> __device__ __forceinline__ void body(const f32x4 (&acc)[2][2][4][2], const Unit& u, const int r16, int wr, int wc, int fr, int fq) const {
        const size_t base = (size_t)(u.pm * 16 + r16 + wr * 4) * 16 * ldc + (size_t)(u.pn * 4 + wc) * 512 + (fr & 7) * 64 + (fr >> 3) * 32 + 8 * fq;
#pragma unroll
        for (int ai = 0; ai < NAI; ++ai)
#pragma unroll
            for (int m = 0; m < 4; ++m) { bf16_t* p = O + base + (size_t)(ai * 8 + m) * 16 * ldc;
                f32x4 h[2];
#pragma unroll
                for (int n = 0; n < 2; ++n) { const f32x4 a = acc[ai][0][m][n], b = acc[ai][1][m][n];
#pragma unroll
                    for (int j = 0; j < 4; ++j) h[n][j] = a[j] * sigmoid_f(a[j]) * b[j]; }
                st16<MK_NT_Z>(p, pack8(h[0], h[1])); }
    }
};
struct EpiMerge {
    static constexpr bool PERM = true, AFTER_DRAIN = false, HAS_MID = true;
    bf16_t* O; int ldc; int mid_t; const bf16_t* Z; int ldz; int ga_off, gb_off;
    __device__ __forceinline__ void mid(f32x4 (&acc)[2][2][4][2], const Unit& u, int wr, int wc, int fr, int fq) const {
        int lane8 = (fq * 16 + fr) * 8;
        asm volatile("" : "+v"(lane8));
        u32x4 wa[2][4][2];
        const size_t gb0 = (size_t)((u.pm * 16 + wr * 4) * 16 + u.pn) * ldz + ga_off + wc * 512 + lane8;
#pragma unroll
        for (int ai = 0; ai < 2; ++ai)
#pragma unroll
            for (int m = 0; m < 4; ++m) { const bf16_t* zr = Z + gb0 + (size_t)((ai * 8 + m) * 16) * ldz;
#pragma unroll
                for (int bj = 0; bj < 2; ++bj) wa[ai][m][bj] = *(const u32x4*)(zr + bj * 2048); }
#pragma unroll
        for (int ai = 0; ai < 2; ++ai)
#pragma unroll
            for (int m = 0; m < 4; ++m)
#pragma unroll
                for (int bj = 0; bj < 2; ++bj) { f32x4 a0, a1; unpack8(wa[ai][m][bj], a0, a1); acc[ai][bj][m][0] *= a0; acc[ai][bj][m][1] *= a1; }
    }
    __device__ __forceinline__ void operator()(const f32x4 (&acc)[2][2][4][2], const Unit& u, int wr, int wc, int fr, int fq) const {
        const int row0 = u.pm * BM + wr * 64 + fr, col0 = u.pn * BM + wc * 32 + 8 * fq;
        u32x4 wb[2][4][2];
#pragma unroll
        for (int ai = 0; ai < 2; ++ai)
#pragma unroll
            for (int m = 0; m < 4; ++m) { const bf16_t* zr = Z + (size_t)((u.pm * 16 + wr * 4 + ai * 8 + m) * 16 + u.pn + 8) * ldz + ga_off + wc * 512 + (fq * 16 + fr) * 8;
#pragma unroll
                for (int bj = 0; bj < 2; ++bj) wb[ai][m][bj] = *(const u32x4*)(zr + bj * 2048); }
#pragma unroll
        for (int ai = 0; ai < 2; ++ai)
#pragma unroll
            for (int m = 0; m < 4; ++m) { bf16_t* rowp = O + (size_t)(row0 + ai * HALF + m * 16) * ldc + col0;
#pragma unroll
                for (int bj = 0; bj < 2; ++bj) { f32x4 b0, b1; unpack8(wb[ai][m][bj], b0, b1);
                    *(u32x4*)(rowp + bj * HALF) = pack8(acc[ai][bj][m][0] * b0, acc[ai][bj][m][1] * b1); } }
    }
};

template <class Epi, class Sched, bool ALIGN_EPI = false, bool SP2 = false, bool ABL = false, bool HU = false>
__device__ __forceinline__ void gemm_phase(PG8_LAS unsigned char* lds, const Gemm g, const Sched& S, const Epi& E) {
    int tid = threadIdx.x; asm volatile("" : "+v"(tid));
    const int wid = __builtin_amdgcn_readfirstlane(tid >> 6), lane = tid & 63, wr = wid >> 2, wc = wid & 3, fr = lane & 15, fq = lane >> 4;
    const int K = g.K, nt = K / BK;
    unsigned voffA[2], voffB[2];
#pragma unroll
    for (int i = 0; i < 2; ++i) { int R, C; stage_rc(tid * 16 + i * 8192, R, C); const int Rb = Epi::PERM ? ((R & ~31) + perm32(R & 31)) : R;
        voffA[i] = ABL ? (unsigned)((R >> 4) * (16 * K) + (C >> 5) * 512 + (R & 7) * 64 + ((R >> 3) & 1) * 32 + (C & 31)) * 2u : (unsigned)(R * K + C) * 2u; voffB[i] = (unsigned)(Rb * K + C) * 2u; }
    const size_t kstep = (size_t)(BK * 2);
    const size_t kstepA = ABL ? (size_t)(BK / 32) * 1024 : kstep;
    const size_t hstep = (size_t)HALF * K * 2;
    unsigned voffA1[2] = {HU ? 0u : voffA[0], HU ? 0u : voffA[1]};
    const size_t hstepA = HU ? 0 : hstep; static_assert(!HU || (SP2 && !ABL && !Epi::HAS_MID), "HALF units: SP2 schedule, row-major A, no mid hook");
    const size_t tstep = 2 * hstep;
    const unsigned ldsw = (unsigned)wid * 1024u;
    const int aoff = lds_byte(wr * 64 + fr, fq * 8), boff = lds_byte(wc * 32 + fr, fq * 8);
#define PG8_SA(b, h) (((b) * 2 + (h)) * HTB)
#define PG8_SB(b, h) ((4 + (b) * 2 + (h)) * HTB)
#define PG8_STAGE(bufoff, gbase, voff) do { _Pragma("unroll") for (int _i = 0; _i < 2; ++_i) \
        __builtin_amdgcn_global_load_lds((const unsigned*)((const char*)(gbase) + (voff)[_i]), (PG8_LAS unsigned*)(lds + (bufoff) + ldsw + _i * 8192), 16, 0, 0); } while (0)
#define PG8_LDA(dst, b, h) do { _Pragma("unroll") for (int m = 0; m < 4; ++m) _Pragma("unroll") for (int k = 0; k < 2; ++k) dst[m][k] = *(const PG8_LAS bf16x8*)(lds + PG8_SA(b, h) + aoff + m * 2048 + k * 1024); } while (0)
#define PG8_LDB(dst, b, h) do { _Pragma("unroll") for (int n = 0; n < 2; ++n) _Pragma("unroll") for (int k = 0; k < 2; ++k) dst[n][k] = *(const PG8_LAS bf16x8*)(lds + PG8_SB(b, h) + boff + n * 2048 + k * 1024); } while (0)
#define PG8_MMA(ai, bj, At, Bt) do { __builtin_amdgcn_s_setprio(1); _Pragma("unroll") for (int m = 0; m < 4; ++m) _Pragma("unroll") for (int n = 0; n < 2; ++n) _Pragma("unroll") for (int k = 0; k < 2; ++k) \
        acc[ai][bj][m][n] = __builtin_amdgcn_mfma_f32_16x16x32_bf16(Bt[n][k], At[m][k], acc[ai][bj][m][n], 0, 0, 0); __builtin_amdgcn_s_setprio(0); } while (0)
#define PG8_WAIT_V(n) asm volatile("s_waitcnt vmcnt(" #n ")" ::: "memory")
#define PG8_WAIT_L(n) asm volatile("s_waitcnt lgkmcnt(" #n ")" ::: "memory")
#define PG8_BAR __builtin_amdgcn_s_barrier()
#define PG8_SCHED __builtin_amdgcn_sched_barrier(0)
    Unit cur, nxt; int ui = 0;
    if (!S.next(0, cur)) return;
    f32x4 acc[2][2][4][2];
#pragma unroll
    for (int a = 0; a < 2; ++a)
#pragma unroll
        for (int b = 0; b < 2; ++b)
#pragma unroll
            for (int m = 0; m < 4; ++m)
#pragma unroll
                for (int n = 0; n < 2; ++n) acc[a][b][m][n] = (f32x4){0.f, 0.f, 0.f, 0.f};
    bf16x8 At[4][2], B0[2][2], B1[2][2];
    const char* cA = (const char*)g.A + (size_t)cur.pm * tstep + (HU ? (size_t)cur.hf * hstep : 0); const char* cB = (const char*)g.Bt + (size_t)cur.pn * tstep;
    S.a_ready(cur);
    if constexpr (SP2) {
        PG8_STAGE(PG8_SB(0, 0), cB, voffB); PG8_STAGE(PG8_SB(0, 1), cB + hstep, voffB); PG8_STAGE(PG8_SA(0, 0), cA, voffA); PG8_STAGE(PG8_SA(0, 1), cA + hstepA, voffA1);
        if (wr == 1) PG8_BAR;
        PG8_WAIT_V(2); PG8_BAR;
        PG8_STAGE(PG8_SB(1, 0), cB + kstep, voffB); PG8_STAGE(PG8_SA(1, 0), cA + kstepA, voffA); PG8_STAGE(PG8_SB(1, 1), cB + hstep + kstep, voffB);
        PG8_WAIT_V(6); PG8_BAR;
    } else {
        PG8_STAGE(PG8_SB(0, 0), cB, voffB); PG8_STAGE(PG8_SA(0, 0), cA, voffA); PG8_STAGE(PG8_SB(0, 1), cB + hstep, voffB); PG8_STAGE(PG8_SA(0, 1), cA + hstep, voffA);
        if (wr == 1) PG8_BAR;
        PG8_WAIT_V(4); PG8_BAR;
        PG8_STAGE(PG8_SB(1, 0), cB + kstep, voffB); PG8_STAGE(PG8_SA(1, 0), cA + kstepA, voffA); PG8_STAGE(PG8_SB(1, 1), cB + hstep + kstep, voffB);
        PG8_WAIT_V(6); PG8_BAR;
    }
    for (;;) {
        const bool has_next = S.next(ui + 1, nxt);
        const char* nA = has_next ? (const char*)g.A + (size_t)nxt.pm * tstep + (HU ? (size_t)nxt.hf * hstep : 0) : cA; const char* nB = has_next ? (const char*)g.Bt + (size_t)nxt.pn * tstep : cB;
        for (int t = 0; t < nt; t += 2) {
            const bool last = (t == nt - 2);
            if constexpr (Epi::HAS_MID) { if (t == E.mid_t) E.mid(acc, cur, wr, wc, fr, fq); }
            const char* a1 = cA + (size_t)(t + 1) * kstepA;
            const char* a2 = last ? nA : cA + (size_t)(t + 2) * kstepA; const char* b2 = last ? nB : cB + (size_t)(t + 2) * kstep;
            const char* a3 = a2 + kstepA; const char* b3 = b2 + kstep;
            if (last && has_next) S.a_ready(nxt);
            if constexpr (SP2) {
            PG8_LDB(B0, 0, 0); PG8_LDB(B1, 0, 1); PG8_SCHED; PG8_LDA(At, 0, 0); PG8_STAGE(PG8_SA(1, 1), a1 + hstepA, voffA1);
            PG8_WAIT_V(8); PG8_WAIT_L(0); PG8_BAR; PG8_MMA(0, 0, At, B0); PG8_MMA(0, 1, At, B1); PG8_BAR; PG8_SCHED;
            if constexpr (!HU) PG8_LDA(At, 0, 1); PG8_STAGE(PG8_SB(0, 0), b2, voffB); PG8_STAGE(PG8_SB(0, 1), b2 + hstep, voffB); PG8_STAGE(PG8_SA(0, 0), a2, voffA);
            PG8_WAIT_V(8); PG8_WAIT_L(0); PG8_BAR; if constexpr (!HU) { PG8_MMA(1, 0, At, B0); PG8_MMA(1, 1, At, B1); } PG8_BAR; PG8_SCHED;
            PG8_LDB(B0, 1, 0); PG8_LDB(B1, 1, 1); PG8_SCHED; PG8_LDA(At, 1, 0); PG8_STAGE(PG8_SA(0, 1), a2 + hstepA, voffA1);
            PG8_WAIT_V(8); PG8_WAIT_L(0); PG8_BAR; PG8_MMA(0, 0, At, B0); PG8_MMA(0, 1, At, B1); PG8_BAR; PG8_SCHED;
            if constexpr (!HU) PG8_LDA(At, 1, 1); PG8_STAGE(PG8_SB(1, 0), b3, voffB); PG8_STAGE(PG8_SB(1, 1), b3 + hstep, voffB); PG8_STAGE(PG8_SA(1, 0), a3, voffA);
            PG8_WAIT_V(8); PG8_WAIT_L(0); PG8_BAR; if constexpr (!HU) { PG8_MMA(1, 0, At, B0); PG8_MMA(1, 1, At, B1); } PG8_BAR; PG8_SCHED;
            } else {
            PG8_LDB(B0, 0, 0); PG8_SCHED; PG8_LDA(At, 0, 0); PG8_STAGE(PG8_SA(1, 1), a1 + hstep, voffA);
            PG8_WAIT_L(8); PG8_BAR; PG8_WAIT_L(0); PG8_MMA(0, 0, At, B0); PG8_BAR; PG8_SCHED;
            PG8_LDB(B1, 0, 1); PG8_STAGE(PG8_SB(0, 0), b2, voffB);
            PG8_BAR; PG8_WAIT_L(0); PG8_MMA(0, 1, At, B1); PG8_BAR;
            PG8_LDA(At, 0, 1); PG8_STAGE(PG8_SA(0, 0), a2, voffA);
            PG8_BAR; PG8_WAIT_L(0); PG8_MMA(1, 0, At, B0); PG8_BAR; PG8_SCHED;
            PG8_STAGE(PG8_SB(0, 1), b2 + hstep, voffB);
            PG8_WAIT_V(6); PG8_BAR; PG8_MMA(1, 1, At, B1); PG8_BAR;
            PG8_LDB(B0, 1, 0); PG8_SCHED; PG8_LDA(At, 1, 0); PG8_STAGE(PG8_SA(0, 1), a2 + hstep, voffA);
            PG8_WAIT_L(8); PG8_BAR; PG8_WAIT_L(0); PG8_MMA(0, 0, At, B0); PG8_BAR; PG8_SCHED;
            PG8_LDB(B1, 1, 1); PG8_STAGE(PG8_SB(1, 0), b3, voffB);
            PG8_BAR; PG8_WAIT_L(0); PG8_MMA(0, 1, At, B1); PG8_BAR;
            PG8_LDA(At, 1, 1); PG8_STAGE(PG8_SA(1, 0), a3, voffA);
            PG8_BAR; PG8_WAIT_L(0); PG8_MMA(1, 0, At, B0); PG8_BAR; PG8_SCHED;
            PG8_STAGE(PG8_SB(1, 1), b3 + hstep, voffB);
            PG8_WAIT_V(6); PG8_BAR; PG8_MMA(1, 1, At, B1); PG8_BAR;
            }
        }
        if constexpr (ALIGN_EPI) { if (wr == 0) PG8_BAR; }
        if constexpr (!Epi::AFTER_DRAIN) { if constexpr (HU) E.half(acc, cur, wr, wc, fr, fq); else E(acc, cur, wr, wc, fr, fq); S.done(cur); }
        if (!has_next) break;
#pragma unroll
        for (int a = 0; a < 2; ++a)
#pragma unroll
            for (int b = 0; b < 2; ++b)
#pragma unroll
                for (int m = 0; m < 4; ++m)
#pragma unroll
                    for (int n = 0; n < 2; ++n) acc[a][b][m][n] = (f32x4){0.f, 0.f, 0.f, 0.f};
        cur = nxt; cA = nA; cB = nB; ++ui;
        if constexpr (ALIGN_EPI) { if (wr == 1) PG8_BAR; }
    }
    PG8_WAIT_V(0);
    if constexpr (!ALIGN_EPI) { if (wr == 0) PG8_BAR; }
    PG8_BAR;
    if constexpr (Epi::AFTER_DRAIN) { E.fused(acc, cur, wr, wc, fr, fq, lds, wid, lane); S.done(cur); }
#undef PG8_SA
#undef PG8_SB
#undef PG8_STAGE
#undef PG8_LDA
#undef PG8_LDB
#undef PG8_MMA
#undef PG8_WAIT_V
#undef PG8_WAIT_L
#undef PG8_BAR
#undef PG8_SCHED
}
}
namespace att {
constexpr int   D = 128, NW = 8, QBLK = 32, KVBLK = 64;
constexpr float SCALE = 0.088388347648318440f;
constexpr float THR = 8.f;
constexpr int LDQ = 7168, LDK = 7168, LDO = 2048;
constexpr int SHM_V = KVBLK * D * 2, SHM_K = KVBLK * D * 2, SHM_ATTN = 2 * SHM_V + 2 * SHM_K + NW * 64 * 4;
typedef unsigned short bf16;
using bf16x8 = __attribute__((ext_vector_type(8))) short;
using s16x4  = __attribute__((ext_vector_type(4))) short;
using f32x16 = __attribute__((ext_vector_type(16))) float;
using u32x4  = __attribute__((ext_vector_type(4))) unsigned;
#define KSWZ(row, colB) ((row) * 256 + ((colB) ^ (((row) & 7) << 4)))
#define SBAR() __builtin_amdgcn_sched_barrier(0)
__device__ __forceinline__ int crow(int r, int hi) { return (r & 3) + 8 * (r >> 2) + 4 * hi; }
typedef float f32x2_t __attribute__((ext_vector_type(2))); typedef __bf16 bf16x2_t __attribute__((ext_vector_type(2)));
__device__ __forceinline__ unsigned cvtpk(float lo, float hi) { f32x2_t v = {lo, hi}; bf16x2_t b = __builtin_convertvector(v, bf16x2_t); return __builtin_bit_cast(unsigned, b); }

__device__ __forceinline__ void partialSM(f32x16& p0, f32x16& p1, float& m_reg, float& mn, float& alpha) {
  constexpr float C = SCALE * 1.4426950408889634f;
  float pmax = p0[0]; for (int r = 1; r < 16; ++r) pmax = fmaxf(pmax, p0[r]); for (int r = 0; r < 16; ++r) pmax = fmaxf(pmax, p1[r]);
  { auto rr = __builtin_amdgcn_permlane32_swap(__float_as_uint(pmax), __float_as_uint(pmax), false, false);
    pmax = fmaxf(__uint_as_float(rr[0]), __uint_as_float(rr[1])); }
  if (__builtin_expect(__all(pmax - m_reg <= THR / SCALE), 1)) { mn = m_reg; alpha = 1.f; }
  else { mn = fmaxf(m_reg, pmax); alpha = __builtin_amdgcn_exp2f((m_reg - mn) * C); m_reg = mn; }
  float mnC = -mn * C;
  for (int r = 0; r < 16; ++r) p0[r] = fmaf(p0[r], C, mnC); for (int r = 0; r < 16; ++r) p1[r] = fmaf(p1[r], C, mnC);
  for (int r = 0; r < 16; ++r) p0[r] = __builtin_amdgcn_exp2f(p0[r]);
}
__device__ __forceinline__ void partialSM_nomax(f32x16& p0) { for (int r = 0; r < 16; ++r) p0[r] = __builtin_amdgcn_exp2f(p0[r]); }
__device__ __forceinline__ void finishSM(f32x16& p0, f32x16& p1, float alpha, float& l_reg, bf16x8& pa0, bf16x8& pa1, bf16x8& pa2, bf16x8& pa3) {
  for (int r = 0; r < 16; ++r) p1[r] = __builtin_amdgcn_exp2f(p1[r]);
  float ps = 0; for (int r = 0; r < 16; ++r) ps += p0[r]; for (int r = 0; r < 16; ++r) ps += p1[r];
  { auto rr = __builtin_amdgcn_permlane32_swap(__float_as_uint(ps), __float_as_uint(ps), false, false);
    ps = __uint_as_float(rr[0]) + __uint_as_float(rr[1]); }
  l_reg = l_reg * alpha + ps;
#define PK4(P, BASE, OUT) do { unsigned a0 = cvtpk(P[BASE + 0], P[BASE + 1]), a1 = cvtpk(P[BASE + 2], P[BASE + 3]);   \
    unsigned b0 = cvtpk(P[BASE + 4], P[BASE + 5]), b1 = cvtpk(P[BASE + 6], P[BASE + 7]);                              \
    auto r0 = __builtin_amdgcn_permlane32_swap(a0, b0, false, false); auto r1 = __builtin_amdgcn_permlane32_swap(a1, b1, false, false); \
    u32x4 w = {r0[0], r1[0], r0[1], r1[1]}; OUT = *reinterpret_cast<bf16x8*>(&w); } while (0)
  PK4(p0, 0, pa0); PK4(p0, 8, pa1); PK4(p1, 0, pa2); PK4(p1, 8, pa3);
#undef PK4
}
__device__ __forceinline__ void qkt(f32x16& p0, f32x16& p1, const bf16* Ks, const bf16x8* qr, int r32, int hi, float init = 0.f) {
  for (int r = 0; r < 16; ++r) { p0[r] = init; p1[r] = init; }
  for (int d0 = 0; d0 < 8; ++d0) { int cb = (d0 * 16 + hi * 8) * 2;
    bf16x8 b0 = *reinterpret_cast<const bf16x8*>((const char*)Ks + KSWZ(r32, cb));
    bf16x8 b1 = *reinterpret_cast<const bf16x8*>((const char*)Ks + KSWZ(32 + r32, cb));
    p0 = __builtin_amdgcn_mfma_f32_32x32x16_bf16(b0, qr[d0], p0, 0, 0, 0);
    p1 = __builtin_amdgcn_mfma_f32_32x32x16_bf16(b1, qr[d0], p1, 0, 0, 0); }
}
__device__ __forceinline__ void wmask(f32x16& p0, f32x16& p1, int dk0, int hi) {
#pragma unroll
  for (int r = 0; r < 16; ++r) { const int d = dk0 + crow(r, hi); p0[r] = (d >= -128 && d <= 128) ? p0[r] : -1e30f; const int e = d + 32; p1[r] = (e >= -128 && e <= 128) ? p1[r] : -1e30f; }
}
__device__ __forceinline__ int v_st(int k, int c) { const int kk = (k & ~0xC) | ((k & 4) << 1) | ((k & 8) >> 1); return ((kk >> 3) * 4 + (c >> 5)) * 512 + ((kk & 7) * 32 + (c & 31)) * 2; }
__device__ __forceinline__ int v_rd_base(int lane) { return ((lane & 3) << 3) | (((lane >> 2) & 3) << 6) | (((lane >> 4) & 1) << 5) | (((lane >> 5) & 1) << 8); }
constexpr int v_rd_off(int d0, int ks, int half) { return d0 * 512 + ks * 4096 + half * 2048; }
template <int OFF> __device__ __forceinline__ s16x4 tr_read(int vb) {
  s16x4 r; asm volatile("ds_read_b64_tr_b16 %0, %1 offset:%2" : "=&v"(r) : "v"(vb), "i"(OFF) : "memory"); return r;
}
template <int D0> __device__ __forceinline__ void pv_one(f32x16& od, int vb, bf16x8 pa0, bf16x8 pa1, bf16x8 pa2, bf16x8 pa3) {
  const s16x4 l0 = tr_read<v_rd_off(D0, 0, 0)>(vb), h0 = tr_read<v_rd_off(D0, 0, 1)>(vb), l1 = tr_read<v_rd_off(D0, 1, 0)>(vb), h1 = tr_read<v_rd_off(D0, 1, 1)>(vb);
  const s16x4 l2 = tr_read<v_rd_off(D0, 2, 0)>(vb), h2 = tr_read<v_rd_off(D0, 2, 1)>(vb), l3 = tr_read<v_rd_off(D0, 3, 0)>(vb), h3 = tr_read<v_rd_off(D0, 3, 1)>(vb);
  asm volatile("s_waitcnt lgkmcnt(0)" ::: "memory"); SBAR();
#define PK(L, H) (bf16x8){L[0], L[1], L[2], L[3], H[0], H[1], H[2], H[3]}
  od = __builtin_amdgcn_mfma_f32_32x32x16_bf16(pa0, PK(l0, h0), od, 0, 0, 0);
  od = __builtin_amdgcn_mfma_f32_32x32x16_bf16(pa1, PK(l1, h1), od, 0, 0, 0);
  od = __builtin_amdgcn_mfma_f32_32x32x16_bf16(pa2, PK(l2, h2), od, 0, 0, 0);
  od = __builtin_amdgcn_mfma_f32_32x32x16_bf16(pa3, PK(l3, h3), od, 0, 0, 0);
#undef PK
}
__device__ __forceinline__ void pv_d0(f32x16* o, int vb, bf16x8 pa0, bf16x8 pa1, bf16x8 pa2, bf16x8 pa3) {
  pv_one<0>(o[0], vb, pa0, pa1, pa2, pa3); pv_one<1>(o[1], vb, pa0, pa1, pa2, pa3); pv_one<2>(o[2], vb, pa0, pa1, pa2, pa3); pv_one<3>(o[3], vb, pa0, pa1, pa2, pa3);
}

struct Stage1 { bf16x8 vs0, vs1, ks0, ks1; };
struct Carry { bf16x8 qr[8]; Stage1 st; };
template <bool WIN, int SDEPTH = 2>
__device__ __forceinline__ void attn_body(const bf16* __restrict__ Qb, const bf16* __restrict__ Kh, const bf16* __restrict__ Vh,
                                          bf16* __restrict__ Ob, int ntiles, int dq0, float sink, float sinkB, char* lds,
                                          Carry& cy, bool preloaded, const bf16* __restrict__ nQb, const bf16* __restrict__ nKh, const bf16* __restrict__ nVh, bool has_next) {
  int tid = threadIdx.x; asm volatile("" : "+v"(tid));
  const int wid = __builtin_amdgcn_readfirstlane(tid >> 6), lane = tid & 63, r32 = lane & 31, hi = lane >> 5;
  bf16* V_lds = (bf16*)lds; bf16* K_lds = (bf16*)(lds + 2 * SHM_V);
  float* ws = (float*)(lds + 2 * SHM_V + 2 * SHM_K) + wid * 64; float* li_l = ws; float* al_l = ws + 32;
  const int wrow = WIN ? (wid & 3) * QBLK : wid * QBLK, hsel = WIN ? (wid >> 2) * D : 0;
  float m_reg = WIN ? (hsel ? sinkB : sink) * (1.0f / SCALE) : -1e30f, l_reg = WIN ? 1.f : 0.f; f32x16 o[4] = {}; bf16x8 (&qr)[8] = cy.qr;
  if (!preloaded) { const bf16* Qw = Qb + (long)(wrow + r32) * LDQ + hsel + hi * 8;
#pragma unroll
    for (int d0 = 0; d0 < 8; ++d0) qr[d0] = *reinterpret_cast<const bf16x8*>(Qw + d0 * 16); }
  const int sr = tid >> 4, sc = (tid & 15) * 8, vst0 = v_st(sr, sc), vst1 = v_st(32 + sr, sc);
  const int vb0 = (int)(uintptr_t)V_lds + v_rd_base(lane);
  const int dkl = dq0 - (wrow + r32);
  static_assert(SDEPTH == 1, "cross-unit prefetch uses the single staging slot"); Stage1 (&sr_)[1] = reinterpret_cast<Stage1 (&)[1]>(cy.st);
#define SLOADP(Kp, Vp) do { sr_[0].vs0 = *reinterpret_cast<const bf16x8*>(&(Vp)[(long)sr * LDK + sc]); sr_[0].vs1 = *reinterpret_cast<const bf16x8*>(&(Vp)[(long)(32 + sr) * LDK + sc]); \
    sr_[0].ks0 = *reinterpret_cast<const bf16x8*>(&(Kp)[(long)sr * LDK + sc]); sr_[0].ks1 = *reinterpret_cast<const bf16x8*>(&(Kp)[(long)(32 + sr) * LDK + sc]); } while (0)
#define SLOAD(i, k0) do { sr_[i].vs0 = *reinterpret_cast<const bf16x8*>(&Vh[(long)((k0) + sr) * LDK + sc]); sr_[i].vs1 = *reinterpret_cast<const bf16x8*>(&Vh[(long)((k0) + 32 + sr) * LDK + sc]); \
    sr_[i].ks0 = *reinterpret_cast<const bf16x8*>(&Kh[(long)((k0) + sr) * LDK + sc]); sr_[i].ks1 = *reinterpret_cast<const bf16x8*>(&Kh[(long)((k0) + 32 + sr) * LDK + sc]); } while (0)
#define SWRITE(b, i) do { *(bf16x8*)((char*)V_lds + (b) * SHM_V + vst0) = sr_[i].vs0;          \
    *(bf16x8*)((char*)V_lds + (b) * SHM_V + vst1) = sr_[i].vs1; int kc = sc * 2;               \
    *(bf16x8*)((char*)K_lds + (b) * SHM_K + KSWZ(sr, kc)) = sr_[i].ks0;                       \
    *(bf16x8*)((char*)K_lds + (b) * SHM_K + KSWZ(32 + sr, kc)) = sr_[i].ks1; } while (0)
#define SWAIT() do { if constexpr (SDEPTH == 2) asm volatile("s_waitcnt vmcnt(4)" ::: "memory"); else asm volatile("s_waitcnt vmcnt(0)" ::: "memory"); } while (0)
#define RESC(a) do { if (__any((a) < 1.f)) { if (hi == 0) al_l[r32] = (a); asm volatile("s_waitcnt lgkmcnt(0)" ::: "memory"); \
    for (int d = 0; d < 4; ++d) for (int r = 0; r < 16; ++r) o[d][r] *= al_l[crow(r, hi)]; } } while (0)
#define WMASK(P0, P1, j) do { if (WIN) { const int dw = dq0 + (j) * KVBLK - wrow; if (!(dw + 63 <= 128 && dw - 31 >= -128)) wmask(P0, P1, dkl + (j) * KVBLK, hi); } } while (0)
  f32x16 pA0, pA1, pB0, pB1; float mnA, mnB, alA = 1.f, alB = 1.f; bf16x8 pa0, pa1, pa2, pa3; const int NT = ntiles;
  const float acc0 = WIN ? 0.f : sink;
#define PSM(P0, P1, MN, AL) do { if constexpr (WIN) partialSM(P0, P1, m_reg, MN, AL); else partialSM_nomax(P0); } while (0)
#define RESCW(a) do { if constexpr (WIN) RESC(a); } while (0)
  if (wid >= 4) __builtin_amdgcn_s_setprio(1);
  constexpr int SE = 0, SO = SDEPTH - 1;
  if (!preloaded) SLOADP(Kh, Vh);
  asm volatile("s_waitcnt vmcnt(0)" ::: "memory"); SWRITE(0, SE);
  SLOAD(SO, KVBLK); if constexpr (SDEPTH == 2) { if (2 < NT) SLOAD(SE, 2 * KVBLK); }
  __syncthreads();
  qkt(pA0, pA1, K_lds, qr, r32, hi, acc0); WMASK(pA0, pA1, 0); PSM(pA0, pA1, mnA, alA);
  SWAIT(); SWRITE(1, SO); __syncthreads();
  for (int j = 1; j + 1 < NT; j += 2) {
    SBAR(); qkt(pB0, pB1, (bf16*)((char*)K_lds + SHM_K), qr, r32, hi, acc0); WMASK(pB0, pB1, j);
    finishSM(pA0, pA1, alA, l_reg, pa0, pa1, pa2, pa3); SBAR();
    SLOAD(SO, (j + SDEPTH) * KVBLK); SBAR();
    pv_d0(o, vb0, pa0, pa1, pa2, pa3); PSM(pB0, pB1, mnB, alB);
    __syncthreads(); SWAIT(); SWRITE(0, SE);
    RESCW(alB); __syncthreads();
    SBAR(); qkt(pA0, pA1, K_lds, qr, r32, hi, acc0); WMASK(pA0, pA1, j + 1);
    finishSM(pB0, pB1, alB, l_reg, pa0, pa1, pa2, pa3); SBAR();
    if (SDEPTH == 1 || j + 3 < NT) SLOAD(SE, (j + 1 + SDEPTH) * KVBLK); SBAR();
    pv_d0(o, vb0 + (int)SHM_V, pa0, pa1, pa2, pa3); PSM(pA0, pA1, mnA, alA);
    __syncthreads(); SWAIT(); SWRITE(1, SO);
    RESCW(alA); __syncthreads();
  }
  SBAR(); qkt(pB0, pB1, (bf16*)((char*)K_lds + SHM_K), qr, r32, hi, acc0); WMASK(pB0, pB1, NT - 1);
  SBAR();
  if (has_next) { const bf16* Qn = nQb + (long)(wrow + r32) * LDQ + hsel + hi * 8;
#pragma unroll
    for (int d0 = 0; d0 < 8; ++d0) qr[d0] = *reinterpret_cast<const bf16x8*>(Qn + d0 * 16);
    SLOADP(nKh, nVh); }
  SBAR();
  finishSM(pA0, pA1, alA, l_reg, pa0, pa1, pa2, pa3); SBAR();
  pv_d0(o, vb0, pa0, pa1, pa2, pa3); PSM(pB0, pB1, mnB, alB);
  __syncthreads(); RESCW(alB);
  finishSM(pB0, pB1, alB, l_reg, pa0, pa1, pa2, pa3); SBAR();
  pv_d0(o, vb0 + (int)SHM_V, pa0, pa1, pa2, pa3);
  __builtin_amdgcn_s_setprio(0);
  if (hi == 0) li_l[r32] = l_reg; asm volatile("s_waitcnt lgkmcnt(0)" ::: "memory");
  float rli[16];
#pragma unroll
  for (int r = 0; r < 16; ++r) rli[r] = __builtin_amdgcn_rcpf(li_l[crow(r, hi)]);
  __syncthreads();
  unsigned short* stg = (unsigned short*)(lds + wid * 8192);
#pragma unroll
  for (int r = 0; r < 16; ++r) { const int orow = crow(r, hi);
#pragma unroll
    for (int d0 = 0; d0 < 4; ++d0) { const unsigned w = cvtpk(o[d0][r] * rli[r], 0.f); stg[orow * 128 + d0 * 32 + r32] = (unsigned short)w; } }
  asm volatile("s_waitcnt lgkmcnt(0)" ::: "memory");
  bf16* Ow = Ob + (long)wrow * LDO + hsel;
#pragma unroll
  for (int i = 0; i < 8; ++i) { const int idx = i * 64 + lane, row = idx >> 4, c8 = (idx & 15) * 8;
    const u32x4 v = *reinterpret_cast<const u32x4*>(stg + row * 128 + c8);
    *reinterpret_cast<u32x4*>(Ow + (long)row * LDO + c8) = v; }
  __syncthreads();
#undef SLOAD
#undef SLOADP
#undef SWRITE
#undef SWAIT
#undef RESC
#undef WMASK
#undef PSM
#undef RESCW
}
#undef KSWZ
#undef SBAR
}
#ifndef MK_LAUNCH_MODE
#define MK_LAUNCH_MODE 1
#endif
constexpr int NWAVES = 8;
constexpr int DM = 2048, NTOK = 40960, S0 = 8192, S1 = 4096, NBATCH = 9, DEPTH = 4, INW = 7168, DFF = 5632, NMOD = 6 * DM;
constexpr int Z_QA = 0, Z_KA = 1024, Z_VA = 1280, Z_QB = 1536, Z_KB = 2560, Z_VB = 2816, Z_GA = 3072, Z_GB = 5120;
constexpr float EPS = 1e-6f;
constexpr size_t MiB = 1u << 20;
constexpr size_t WS_CTL = 0, CTL_ZERO_BYTES = 1 * MiB;
constexpr size_t WS_MOD = 1 * MiB;
constexpr size_t WS_TAB = 3 * MiB;
constexpr size_t TAB_COS1 = 0, TAB_SIN1 = 8192 * 64, TAB_CR = 2 * 8192 * 64, TAB_SR = TAB_CR + 128 * 32, TAB_CC = TAB_SR + 128 * 32, TAB_SC = TAB_CC + 64 * 32;
constexpr size_t WS_WT = 8 * MiB;
constexpr size_t W_IN = 0, W_BR = W_IN + (size_t)INW * DM, W_OUT = W_BR + (size_t)DM * DM, W_13 = W_OUT + (size_t)DM * DM, W_2 = W_13 + (size_t)2 * DFF * DM, LAYER_W = W_2 + (size_t)DM * DFF;
constexpr size_t WS_U = WS_WT + DEPTH * LAYER_W * 2;
constexpr size_t WS_Z = WS_U + (size_t)NTOK * DM * 2;
constexpr size_t WS_O = WS_Z + (size_t)NTOK * INW * 2;
constexpr size_t WS_MG = WS_U;
constexpr size_t WS_X = WS_O + (size_t)NTOK * DM * 2;
constexpr size_t WS_END = WS_X + (size_t)NTOK * DM * 2;
static_assert(WS_WT % 256 == 0 && WS_U % 256 == 0 && WS_Z % 256 == 0 && WS_O % 256 == 0 && WS_X % 256 == 0, "ws map alignment");
static_assert((size_t)NTOK * DFF * 2 <= (size_t)NTOK * INW * 2, "H overlays Z");
constexpr int CW_TMO = 0, CW_CODE = 1, CW_BAR = 4096;
constexpr int RING_OFF = 0, RING_BYTES = 131072, LDSCTL_OFF = RING_BYTES, MISC_OFF = LDSCTL_OFF + 320, XCH_OFF = LDSCTL_OFF + 1024  , LDS_BYTES = 147456;
static_assert(XCH_OFF + 8192 <= LDS_BYTES, "LDS map");
constexpr int PH_PRO = 0, PH_NORM0 = 1, PH_L0 = 2, PH_PER_LAYER = 8, N_PHASES = PH_L0 + DEPTH * PH_PER_LAYER;

#define GAS __attribute__((address_space(1)))
#define LAS __attribute__((address_space(3)))
typedef unsigned short bf16;
typedef unsigned v4u __attribute__((ext_vector_type(4)));
typedef unsigned v2u __attribute__((ext_vector_type(2)));
typedef float f32x4 __attribute__((ext_vector_type(4)));
typedef GAS unsigned gu32;
#define RLX_AGENT __ATOMIC_RELAXED, __HIP_MEMORY_SCOPE_AGENT
#define LDS_WAIT() asm volatile("s_waitcnt lgkmcnt(0)" ::: "memory")
#define VM_WAIT() asm volatile("s_waitcnt vmcnt(0)" ::: "memory")
__device__ __forceinline__ unsigned f2bf(float f) { unsigned u = __builtin_bit_cast(unsigned, f); return (u + 0x7fffu + ((u >> 16) & 1u)) >> 16; }
__device__ __forceinline__ unsigned pk2(float lo, float hi) { return f2bf(lo) | (f2bf(hi) << 16); }
__device__ __forceinline__ float bflo(unsigned w) { return __uint_as_float(w << 16); }
__device__ __forceinline__ float bfhi(unsigned w) { return __uint_as_float(w & 0xffff0000u); }

#define XB_TMO      128
#define XB_XCNT(j)  (256  + 64 * (j))
#define XB_XSUB(j)  (1280 + 64 * (j))
#define XB_XGEN(j)  (2304 + 64 * (j))
#define XB_TOP      3328
#define XB_TOPGEN   3392
#define XCD_BAR_WORDS 3456
#define XB_SPIN_CAP (1u << 18)

__device__ __forceinline__ unsigned xb_ld(unsigned* p)              { return __hip_atomic_load(p, __ATOMIC_RELAXED, __HIP_MEMORY_SCOPE_AGENT); }
__device__ __forceinline__ unsigned xb_add(unsigned* p, unsigned v) { return __hip_atomic_fetch_add(p, v, __ATOMIC_RELAXED, __HIP_MEMORY_SCOPE_AGENT); }
__device__ __forceinline__ unsigned xb_xcc_id() { return (unsigned)__builtin_amdgcn_s_getreg((3 << 11) | 20) & 0xFu; }
#define XB_SPIN(cond, bar) do { unsigned _sp = 0; while (cond) { __builtin_amdgcn_s_sleep(1); \
    if ((++_sp & 255u) == 0u) { if (xb_ld(&(bar)[XB_TMO])) break; if (_sp > XB_SPIN_CAP) { atomicAdd(&(bar)[XB_TMO], 1u); break; } } } } while (0)

struct XcdBarrier {
    unsigned* bar; unsigned x;
    volatile LAS unsigned* st;
};

__device__ __forceinline__ XcdBarrier xcd_barrier_post(unsigned* bar, volatile LAS unsigned* st) {
    XcdBarrier b; b.bar = bar; b.x = xb_xcc_id(); b.st = st;
    if (threadIdx.x == 0) (void)xb_add(&bar[XB_XCNT(b.x)], 1u);
    return b;
}
__device__ __forceinline__ void xcd_barrier_complete(unsigned* bar, unsigned x, unsigned& nloc, unsigned& nx) {
    const unsigned G = gridDim.x * gridDim.y * gridDim.z;
    unsigned sum, cnt, mine, sp = 0u;
    for (;;) {
        sum = 0u; cnt = 0u; mine = 0u;
#pragma unroll
        for (unsigned j = 0; j < 16; ++j) { const unsigned c = xb_ld(&bar[XB_XCNT(j)]); sum += c; cnt += (c > 0u) ? 1u : 0u; mine = (j == x) ? c : mine; }
        if (sum == G) break;
        __builtin_amdgcn_s_sleep(1);
        if ((++sp & 255u) == 0u) { if (xb_ld(&bar[XB_TMO])) break; if (sp > XB_SPIN_CAP) { atomicAdd(&bar[XB_TMO], 1u); break; } }
    }
    nloc = mine > 0u ? mine : 1u; nx = cnt > 0u ? cnt : 1u;
}

__device__ __forceinline__ void xcd_barrier(const XcdBarrier& b) {
    asm volatile("s_waitcnt vmcnt(0)" ::: "memory");
    __syncthreads();
    if (threadIdx.x == 0) {
        unsigned* bar = b.bar;
        __builtin_amdgcn_s_waitcnt(0);
        unsigned nloc = b.st[0], nx = b.st[1];
        if (nloc == 0u) { xcd_barrier_complete(bar, b.x, nloc, nx); b.st[0] = nloc; b.st[1] = nx; }
        const unsigned old = xb_add(&bar[XB_XSUB(b.x)], 1u);
        const unsigned gen = old / nloc;
        if (old + 1u == (gen + 1u) * nloc) {
            __builtin_amdgcn_fence(__ATOMIC_RELEASE, "agent");
            asm volatile("s_waitcnt vmcnt(0)" ::: "memory");
            const unsigned og = xb_add(&bar[XB_TOP], 1u);
            const unsigned tg = og / nx;
            if (og + 1u == (tg + 1u) * nx) xb_add(&bar[XB_TOPGEN], 1u);
            else XB_SPIN(xb_ld(&bar[XB_TOPGEN]) == tg, bar);
            __builtin_amdgcn_fence(__ATOMIC_ACQUIRE, "agent");
            xb_add(&bar[XB_XGEN(b.x)], 1u);
            asm volatile("s_waitcnt vmcnt(0)" ::: "memory");
        } else {
            XB_SPIN(xb_ld(&bar[XB_XGEN(b.x)]) == gen, bar);
            __builtin_amdgcn_fence(__ATOMIC_ACQUIRE, "agent");
            asm volatile("s_waitcnt vmcnt(0)" ::: "memory");
        }
    }
    __syncthreads();
}


struct Args { const float* in[19]; float* out; unsigned char* ws; int ph_lo, ph_hi, li, pad; };

__device__ __forceinline__ float wave_sum(float v) {
#pragma unroll
    for (int o = 1; o < 64; o <<= 1) v += __shfl_xor(v, o);
    return v;
}
__device__ __forceinline__ int row_batch(int row) { return row < S0 ? 0 : 1 + ((row - S0) >> 12); }
__device__ __forceinline__ int row_pos(int row) { return row < S0 ? row : ((row - S0) & (S1 - 1)); }

__device__ __forceinline__ void sincos_d(double a, float& s, float& c) {
    const double q = __builtin_rint(a * 0.63661977236758134308);
    double r = __builtin_fma(-q, 1.5707963267948966, a); r = __builtin_fma(-q, 6.123233995736766e-17, r);
    const double r2 = r * r;
    double sp = 1.0 / 6227020800.0; sp = sp * r2 - 1.0 / 39916800.0; sp = sp * r2 + 1.0 / 362880.0; sp = sp * r2 - 1.0 / 5040.0; sp = sp * r2 + 1.0 / 120.0; sp = sp * r2 - 1.0 / 6.0; sp = sp * r2 + 1.0; sp = sp * r;
    double cp = -1.0 / 87178291200.0; cp = cp * r2 + 1.0 / 479001600.0; cp = cp * r2 - 1.0 / 3628800.0; cp = cp * r2 + 1.0 / 40320.0; cp = cp * r2 - 1.0 / 720.0; cp = cp * r2 + 1.0 / 24.0; cp = cp * r2 - 0.5; cp = cp * r2 + 1.0;
    const int qi = (int)((long long)q & 3);
    const double ss = (qi & 1) ? cp : sp, cc = (qi & 1) ? sp : cp;
    s = (float)((qi & 2) ? -ss : ss); c = (float)(((qi + 1) & 2) ? -cc : cc);
}
__device__ __forceinline__ float inv_freq(int i, double base) { double v = 1.0; for (int k = 0; k < i; ++k) v *= base; return (float)v; }
__device__ __forceinline__ void p0_tables(float* tab, int gt, int ngt) {
    for (int idx = gt; idx < 8192 * 64; idx += ngt) { const int pos = idx >> 6, i = idx & 63; const float f = inv_freq(i, 0.8659643233600653); const float ang = (float)pos * f;
        float s, c; sincos_d((double)ang, s, c); const int ix = (((pos >> 4) * 16 + (i >> 2)) * 16 + (pos & 15)) * 4 + (i & 3);
        tab[TAB_COS1 + ix] = c; tab[TAB_SIN1 + ix] = s; }
    for (int idx = gt; idx < 128 * 32; idx += ngt) { const int pos = idx >> 5, i = idx & 31; const float f = inv_freq(i, 0.7498942093324558); const float ang = (float)pos * f;
        float s, c; sincos_d((double)ang, s, c); tab[TAB_CR + idx] = c; tab[TAB_SR + idx] = s; if (pos < 64) { const int ix = (((pos >> 4) * 8 + (i >> 2)) * 16 + (pos & 15)) * 4 + (i & 3);
            tab[TAB_CC + ix] = c; tab[TAB_SC + ix] = s; } }
}
__device__ __forceinline__ void p0_mod_item(const float* cp, const float* cs, const float* wmod, const float* bmod, float* mod, LAS float* sc, int item, int tid, int wave, int lane) {
    const int l = item / (NMOD / 256), col0 = (item % (NMOD / 256)) * 256;
    for (int i = tid; i < NBATCH * DM; i += 512) { const float v = (i < DM) ? cp[i] : cs[i - DM]; sc[i] = v * __builtin_amdgcn_rcpf(1.0f + __expf(-v)); }
    __syncthreads();
    f32x4 acc[NBATCH];
#pragma unroll
    for (int b = 0; b < NBATCH; ++b) acc[b] = (f32x4){0.f, 0.f, 0.f, 0.f};
    const float* wp = wmod + (size_t)l * DM * NMOD + (size_t)(wave * 256) * NMOD + col0 + lane * 4;
    for (int k16 = 0; k16 < 16; ++k16) {
        f32x4 w[16];
#pragma unroll
        for (int kk = 0; kk < 16; ++kk) w[kk] = *(const f32x4*)(wp + (size_t)(k16 * 16 + kk) * NMOD);
#pragma unroll
        for (int q = 0; q < 4; ++q)
#pragma unroll
            for (int b = 0; b < NBATCH; ++b) { const f32x4 s4 = *(const LAS f32x4*)(sc + b * DM + wave * 256 + k16 * 16 + q * 4);
                acc[b] += w[4 * q + 0] * s4[0]; acc[b] += w[4 * q + 1] * s4[1]; acc[b] += w[4 * q + 2] * s4[2]; acc[b] += w[4 * q + 3] * s4[3]; }
    }
    __syncthreads();
#pragma unroll
    for (int b = 0; b < NBATCH; ++b) *(LAS f32x4*)(sc + (wave * NBATCH + b) * 256 + lane * 4) = acc[b];
    __syncthreads();
    for (int i = tid; i < NBATCH * 256; i += 512) { const int b = i >> 8, c = i & 255; float s = bmod[(size_t)l * NMOD + col0 + c];
#pragma unroll
        for (int w = 0; w < NWAVES; ++w) s += sc[(w * NBATCH + b) * 256 + c];
        mod[((size_t)l * NBATCH + b) * NMOD + col0 + c] = s; }
    __syncthreads();
}
__device__ __forceinline__ int zperm(int n) {
    if (n >= Z_GA) { const int c = (n - Z_GA) & 2047; return Z_GA + 256 * (c >> 7) + ((n - Z_GA) >> 11) * 128 + (c & 127); }
    const int mode = (n < 1280) ? 1 : (n < 1536) ? 0 : (n < 2816) ? 2 : 0;
    if (mode == 0) return n;
    const int base = n & ~127, e = n & 127;
    if (mode == 1) { const int m = e & 63; return base + 8 * (m >> 2) + 4 * (e >> 6) + (m & 3); }
    const int q = e >> 5, m = e & 31; return base + 8 * ((q >> 1) * 8 + (m >> 2)) + 4 * (q & 1) + (m & 3);
}
constexpr int I_IN = (DM / 64) * (INW / 32), I_BR = (1024 / 64) * (DM / 32), I_OUT = (DM / 64) * (DM / 32), I_13 = (DM / 64) * (2 * DFF / 32), I_2 = (DFF / 64) * (DM / 32);
constexpr int I_LAYER = I_IN + 2 * I_BR + I_OUT + I_13 + I_2;
struct TrItem { const float* src; bf16* dst; int N, ldk, drow0; bool zp; };
template <class AP> __device__ __forceinline__ TrItem tr_decode(AP a, bf16* wt, int it) {
    const int l = it / I_LAYER; int r = it % I_LAYER; bf16* wl = wt + (size_t)l * LAYER_W; TrItem t;
    if (r < I_IN) { const int nb = r % (INW / 32), kb = r / (INW / 32); t.src = a->in[10] + (size_t)l * DM * INW + (size_t)(64 * kb) * INW + 32 * nb; t.N = INW; t.dst = wl + W_IN + 64 * kb; t.ldk = DM; t.drow0 = 32 * nb; t.zp = true; return t; } r -= I_IN;
    if (r < I_BR) { const int nb = r % (DM / 32), kb = r / (DM / 32); t.src = a->in[14] + (size_t)l * 1024 * DM + (size_t)(64 * kb) * DM + 32 * nb; t.N = DM; t.dst = wl + W_BR + 64 * kb; t.ldk = DM; t.drow0 = 32 * nb; t.zp = false; return t; } r -= I_BR;
    if (r < I_BR) { const int nb = r % (DM / 32), kb = r / (DM / 32); t.src = a->in[15] + (size_t)l * 1024 * DM + (size_t)(64 * kb) * DM + 32 * nb; t.N = DM; t.dst = wl + W_BR + 1024 + 64 * kb; t.ldk = DM; t.drow0 = 32 * nb; t.zp = false; return t; } r -= I_BR;
    if (r < I_OUT) { const int nb = r % (DM / 32), kb = r / (DM / 32); t.src = a->in[16] + (size_t)l * DM * DM + (size_t)(64 * kb) * DM + 32 * nb; t.N = DM; t.dst = wl + W_OUT + 64 * kb; t.ldk = DM; t.drow0 = 32 * nb; t.zp = false; return t; } r -= I_OUT;
    if (r < I_13) { const int nb = r % (2 * DFF / 32), kb = r / (2 * DFF / 32); const int n0 = 32 * nb; const int j = n0 < DFF ? n0 : n0 - DFF; const int drow = 256 * (j >> 7) + (n0 < DFF ? 0 : 128) + (j & 127);
        t.src = a->in[17] + (size_t)l * DM * 2 * DFF + (size_t)(64 * kb) * (2 * DFF) + n0; t.N = 2 * DFF; t.dst = wl + W_13 + 64 * kb; t.ldk = DM; t.drow0 = drow; t.zp = false; return t; } r -= I_13;
    { const int nb = r % (DM / 32), kb = r / (DM / 32); t.src = a->in[18] + (size_t)l * DFF * DM + (size_t)(64 * kb) * DM + 32 * nb; t.N = DM; t.dst = wl + W_2 + 64 * kb; t.ldk = DFF; t.drow0 = 32 * nb; t.zp = false; return t; }
}
__device__ __forceinline__ void tr_load(const TrItem& t, float (&wv)[32], int lane) {
#pragma unroll
    for (int i = 0; i < 32; ++i) { const int kk = 2 * i + (lane >> 5); wv[i] = t.src[(size_t)kk * t.N + (lane & 31)]; }
}
__device__ __forceinline__ void tr_store(const TrItem& t, const float (&wv)[32], LAS float* scr, int lane) {
#pragma unroll
    for (int i = 0; i < 32; ++i) { const int kk = 2 * i + (lane >> 5); scr[kk * 33 + (lane & 31)] = wv[i]; }
    LDS_WAIT(); asm volatile("" ::: "memory");
    const int c = lane & 7;
#pragma unroll
    for (int j = 0; j < 4; ++j) { const int n = (lane >> 3) + 8 * j; const LAS float* s = scr + (8 * c) * 33 + n;
        v4u o; o.x = pk2(s[0 * 33], s[1 * 33]); o.y = pk2(s[2 * 33], s[3 * 33]); o.z = pk2(s[4 * 33], s[5 * 33]); o.w = pk2(s[6 * 33], s[7 * 33]);
        const int dr = t.zp ? zperm(t.drow0 + n) : t.drow0 + n;
        *(GAS v4u*)(t.dst + (size_t)dr * t.ldk + 8 * c) = o; }
    LDS_WAIT(); asm volatile("" ::: "memory");
}
template <class AP> __device__ __forceinline__ void p0_transposes(AP a, bf16* wt, LAS float* scr, int it0, int it1, int gw, int ngw, int lane) {
    int it = it0 + gw; if (it >= it1) return;
    float wa[32], wb[32]; TrItem cur = tr_decode(a, wt, it); tr_load(cur, wa, lane);
    for (;;) {
        int nit = it + ngw; TrItem nxt = cur; const bool hn = nit < it1; if (hn) { nxt = tr_decode(a, wt, nit); tr_load(nxt, wb, lane); }
        tr_store(cur, wa, scr, lane); if (!hn) break;
        it = nit + ngw; const bool h2 = it < it1; if (h2) { cur = tr_decode(a, wt, it); tr_load(cur, wa, lane); }
        tr_store(nxt, wb, scr, lane); if (!h2) break;
    }
}

template <int MODE, bool DO_U>
__device__ __forceinline__ void norm_phase(const float* xin, const float* xin2, bf16* xb, float* xout, const bf16* y, bf16* u, const float* g_post, const float* gate, const float* g_pre, const float* scale, const float* shift,
                                           int gw, int ngw, int lane) {
    const int rpw = (NTOK + ngw - 1) / ngw, r0 = gw * rpw, r1 = (r0 + rpw < NTOK) ? r0 + rpw : NTOK;
    f32x4 A[8], Bv[8], Cv[8]; int curb = -1;
    const int cl = 4 * lane, yp = 64 * ((cl >> 5) & 3) + 32 * (cl >> 7) + (cl & 31);
    v2u xw[8], yw[8];
#define NORM_FETCH(row_) do { const bf16* xr_ = xb + (size_t)(row_) * DM + 4 * lane; const bf16* yr_ = y + (size_t)(row_) * DM + yp; \
        _Pragma("unroll") for (int j = 0; j < 8; ++j) xw[j] = *(const v2u*)(xr_ + 256 * j); _Pragma("unroll") for (int j = 0; j < 8; ++j) yw[j] = *(const v2u*)(yr_ + 256 * j); } while (0)
    if (MODE == 1 && r0 < r1) NORM_FETCH(r0);
    f32x4 xf[8];
    if (MODE == 0 && r0 < r1) { const float* xr = (r0 < S0 ? xin + (size_t)r0 * DM : xin2 + (size_t)(r0 - S0) * DM) + 4 * lane;
#pragma unroll
        for (int j = 0; j < 8; ++j) xf[j] = *(const f32x4*)(xr + 256 * j); }
    for (int row = r0; row < r1; ++row) {
        const int b = row_batch(row);
        if (b != curb) { curb = b; int l4 = 4 * lane; asm volatile("" : "+v"(l4));
#pragma unroll
            for (int j = 0; j < 8; ++j) { const int c = 256 * j + l4;
                if (MODE == 1) A[j] = *(const f32x4*)(gate + (size_t)b * NMOD + c) * *(const f32x4*)(g_post + c);
                if (DO_U) { Bv[j] = *(const f32x4*)(g_pre + c) * (*(const f32x4*)(scale + (size_t)b * NMOD + c) + 1.0f); Cv[j] = *(const f32x4*)(shift + (size_t)b * NMOD + c); } } }
        f32x4 x[8];
        if (MODE == 0) {
#pragma unroll
            for (int j = 0; j < 8; ++j) x[j] = xf[j];
            if (row + 1 < r1) { const int rn = row + 1; const float* xr = (rn < S0 ? xin + (size_t)rn * DM : xin2 + (size_t)(rn - S0) * DM) + 4 * lane;
#pragma unroll
                for (int j = 0; j < 8; ++j) xf[j] = *(const f32x4*)(xr + 256 * j); } }
        else {
            float ss = 0.f;
#pragma unroll
            for (int j = 0; j < 8; ++j) { const v2u w = xw[j]; x[j] = (f32x4){bflo(w.x), bfhi(w.x), bflo(w.y), bfhi(w.y)}; }
#pragma unroll
            for (int j = 0; j < 8; ++j) { const v2u w = yw[j]; const f32x4 yv = (f32x4){bflo(w.x), bfhi(w.x), bflo(w.y), bfhi(w.y)}; ss += (yv[0] * yv[0] + yv[1] * yv[1]) + (yv[2] * yv[2] + yv[3] * yv[3]); }
            const float rstd = __builtin_amdgcn_rsqf(wave_sum(ss) * (1.0f / DM) + EPS);
#pragma unroll
            for (int j = 0; j < 8; ++j) { const v2u w = yw[j]; const f32x4 yv = (f32x4){bflo(w.x), bfhi(w.x), bflo(w.y), bfhi(w.y)}; x[j] += A[j] * (yv * rstd); }
            if (row + 1 < r1) NORM_FETCH(row + 1);
        }
        if (DO_U) {
            bf16* xo = xb + (size_t)row * DM + 4 * lane; float ss = 0.f;
#pragma unroll
            for (int j = 0; j < 8; ++j) { v2u w; w.x = pk2(x[j][0], x[j][1]); w.y = pk2(x[j][2], x[j][3]); *(v2u*)(xo + 256 * j) = w; ss += (x[j][0] * x[j][0] + x[j][1] * x[j][1]) + (x[j][2] * x[j][2] + x[j][3] * x[j][3]); }
            const float rstd = __builtin_amdgcn_rsqf(wave_sum(ss) * (1.0f / DM) + EPS);
            bf16* ur = u + (size_t)row * DM + 4 * lane;
#pragma unroll
            for (int j = 0; j < 8; ++j) { const f32x4 v = x[j] * rstd * Bv[j] + Cv[j]; v2u w; w.x = pk2(v[0], v[1]); w.y = pk2(v[2], v[3]); *(v2u*)(ur + 256 * j) = w; }
        } else {
            float* xo = xout + (size_t)row * DM + 4 * lane;
#pragma unroll
            for (int j = 0; j < 8; ++j) *(f32x4*)(xo + 256 * j) = x[j];
        }
    }
#undef NORM_FETCH
}

__device__ __forceinline__ void attn_phase(const bf16* z, bf16* oab, const float* sink, const float* qn, const float* kn, char* lds, int c, int G) {
    const int x = c & 7, jj = c >> 3, per = (G - x + 7) >> 3;
    float nacc0;
    { const int ln = threadIdx.x & 63; float gq = fmaxf(fabsf(qn[ln]), fabsf(qn[ln + 64])), gk = fmaxf(fabsf(kn[ln]), fabsf(kn[ln + 64]));
#pragma unroll
      for (int o = 1; o < 64; o <<= 1) { gq = fmaxf(gq, __shfl_xor(gq, o)); gk = fmaxf(gk, __shfl_xor(gk, o)); }
      const float bnd = 1.01f * 128.0f * 0.12751743082459868f * gq * gk; nacc0 = -fmaxf(bnd - 40.0f, 0.0f); }
#ifndef MK_REPEAT_ATT
#define MK_REPEAT_ATT 0
#endif
    att::Carry cy;
    for (int rep = 0; rep < ((MK_REPEAT_ATT & 1) ? 2 : 1); ++rep) { bool pre = false;
    for (int T = jj; T < 160; T += per) { const bool pr = T < 32; const int w = T - 32, h = pr ? x : (w >> 4), qb = pr ? T : (w & 15); const size_t r0 = pr ? 0 : S0 + (size_t)x * S1;
        const int Tn = T + per; const bool hn = Tn < 160; const bool prn = Tn < 32; const int wn = Tn - 32, hnx = prn ? x : (wn >> 4), qbn = prn ? Tn : (wn & 15); const size_t r0n = prn ? 0 : S0 + (size_t)x * S1;
        att::attn_body<false, 1>(z + (r0 + 256 * qb) * INW + Z_QB + h * 128, z + r0 * INW + Z_KB + (h >> 2) * 128, z + r0 * INW + Z_VB + (h >> 2) * 128,
                                 oab + (r0 + 256 * qb) * DM + 1024 + h * 128, pr ? S0 / 64 : S1 / 64, 0, nacc0, 0.f, lds,
                                 cy, pre, z + (r0n + 256 * qbn) * INW + Z_QB + hnx * 128, z + r0n * INW + Z_KB + (hnx >> 2) * 128, z + r0n * INW + Z_VB + (hnx >> 2) * 128, hn);
        pre = hn; } }
    { bool pre = false;
    for (int LL = jj; LL < 160; LL += per) {
#define WIN_UNIT(L_, row0_, h_, s0_, klo_, khi_) const int pm##L_ = ((L_) >> 3) * 8 + x, row0_ = 256 * pm##L_ + 128 * (((L_) >> 2) & 1), h_ = 2 * ((L_) & 3); \
        const int s0_ = row0_ < S0 ? 0 : S0 + ((row0_ - S0) & ~(S1 - 1)), S##L_ = row0_ < S0 ? S0 : S1, i0##L_ = row0_ - s0_; \
        const int klo_ = i0##L_ - 128 < 0 ? 0 : i0##L_ - 128, khi_ = i0##L_ + 256 > S##L_ ? S##L_ : i0##L_ + 256
        WIN_UNIT(LL, row0, h, s0, klo, khi); const int Ln = LL + per; const bool hn = Ln < 160; WIN_UNIT(Ln, row0n, hnx, s0n, klon, khin); (void)khin;
        att::attn_body<true, 1>(z + (size_t)row0 * INW + Z_QA + h * 128, z + (size_t)(s0 + klo) * INW + Z_KA + (h >> 2) * 128, z + (size_t)(s0 + klo) * INW + Z_VA + (h >> 2) * 128,
                                oab + (size_t)row0 * DM + h * 128, (khi - klo) / 64, klo - (row0 - s0), sink[h], sink[h + 1], lds,
                                cy, pre, z + (size_t)row0n * INW + Z_QA + hnx * 128, z + (size_t)(s0n + klon) * INW + Z_KA + (hnx >> 2) * 128, z + (size_t)(s0n + klon) * INW + Z_VA + (hnx >> 2) * 128, hn);
        pre = hn; }
#undef WIN_UNIT
    }
}

__device__ __forceinline__ void phase_skew(int bx, unsigned ticks) {
    const unsigned long long want = (unsigned long long)(((unsigned)bx >> 3) & 7u) * ticks, t0 = __builtin_amdgcn_s_memrealtime();
    while (__builtin_amdgcn_s_memrealtime() - t0 < want) __builtin_amdgcn_s_sleep(2);
}
#ifndef MK_SKEW
#define MK_SKEW 0
#endif
typedef const __attribute__((address_space(4))) Args* KArgs;
__device__ __forceinline__ KArgs kargs() { KArgs p = (KArgs)__builtin_amdgcn_kernarg_segment_ptr(); asm volatile("" : "+s"(p)); return p; }
#ifndef MK_KIND_MASK
#define MK_KIND_MASK 0x7ff
#endif
#define KIND(n) ((MK_KIND_MASK >> (n)) & 1)
#ifndef MK_REPEAT_MASK
#define MK_REPEAT_MASK 0
#endif
#define NREP(n) (((MK_REPEAT_MASK >> (n)) & 1) ? 2 : 1)
__global__ void __launch_bounds__(NWAVES * 64, 2) mk_fwd(Args args_unused) {
    extern __shared__ __attribute__((aligned(16))) unsigned char lds[];
    LAS unsigned char* L = (LAS unsigned char*)lds;
    volatile LAS unsigned* MISC = (volatile LAS unsigned*)(L + MISC_OFF);
    const int G = gridDim.x, bx = blockIdx.x, ngw = G * NWAVES;
#define PHASE_IDS int tid = threadIdx.x; asm volatile("" : "+v"(tid)); const int lane = tid & 63, wave = __builtin_amdgcn_readfirstlane(tid >> 6), gw = bx * NWAVES + wave; (void)lane; (void)gw
    for (int u = threadIdx.x; u < (LDS_BYTES - LDSCTL_OFF) / 4; u += NWAVES * 64) ((LAS unsigned*)(L + LDSCTL_OFF))[u] = 0u;
    __syncthreads();
    int lo, hi; XcdBarrier bar;
    { KArgs ap = kargs(); lo = ap->ph_lo; hi = ap->ph_hi; unsigned* bw = (unsigned*)(ap->ws + WS_CTL) + CW_BAR + ap->li * XCD_BAR_WORDS;
      bar.bar = bw; bar.x = 0; bar.st = nullptr; if (hi - lo > 1) bar = xcd_barrier_post(bw, MISC + 8); }
#define IN(k) (lo <= (k) && (k) < hi)
#define SEAM(k) do { if ((k) + 1 < hi) xcd_barrier(bar); } while (0)
#define WSP(T, off) ((T*)(ap->ws + (off)))

    if (KIND(0) && IN(PH_PRO)) {
        KArgs ap = kargs(); PHASE_IDS;
            for (int rep = 0; rep < NREP(0); ++rep) {
        p0_tables(WSP(float, WS_TAB), bx * 512 + tid, G * 512);
        for (int it = bx; it < DEPTH * (NMOD / 256); it += G) p0_mod_item(ap->in[2], ap->in[3], ap->in[8], ap->in[9], WSP(float, WS_MOD), (LAS float*)(L + RING_OFF), it, tid, wave, lane);
        p0_transposes(ap, WSP(bf16, WS_WT), (LAS float*)(L + RING_OFF + wave * 16384), 0, DEPTH * I_LAYER, gw, ngw, lane);
            }
        SEAM(PH_PRO);
    }
    if (KIND(1) && IN(PH_NORM0)) {
        KArgs ap = kargs(); PHASE_IDS; const float* mod = WSP(float, WS_MOD);
        norm_phase<0, true>(ap->in[0], ap->in[1], WSP(bf16, WS_X), nullptr, nullptr, WSP(bf16, WS_U), nullptr, nullptr, ap->in[4], mod + 1 * DM, mod + 0 * DM, gw, ngw, lane);
        SEAM(PH_NORM0);
    }
    for (int l = 0; l < DEPTH; ++l) {
        const int pb = PH_L0 + PH_PER_LAYER * l;
        if (KIND(2) && IN(pb + 0)) {
            KArgs ap = kargs(); PHASE_IDS;
            for (int rep = 0; rep < NREP(2); ++rep) {
            pg8::Gemm g{WSP(bf16, WS_U), WSP(bf16, WS_WT) + (size_t)l * LAYER_W + W_IN, NTOK, INW, DM}; pg8::StaticOrder S; S.init(NTOK, INW, G, bx); S.split_tail();
            pg8::EpiZ E{WSP(bf16, WS_Z), INW, WSP(float, WS_TAB), ap->in[11] + l * 128, ap->in[12] + l * 128, (LAS float*)(L + XCH_OFF)};
            static_assert(pg8::EpiZ::tab_cos1 == TAB_COS1 && pg8::EpiZ::tab_sin1 == TAB_SIN1 && pg8::EpiZ::tab_cr == TAB_CR && pg8::EpiZ::tab_sr == TAB_SR && pg8::EpiZ::tab_cc == TAB_CC && pg8::EpiZ::tab_sc == TAB_SC, "table offsets");
            pg8::gemm_phase<pg8::EpiZ, pg8::StaticOrder, true, true>(L + RING_OFF, g, S, E);
            { pg8::TailOrder T{S}; pg8::gemm_phase<pg8::EpiZ, pg8::TailOrder, true, true, false, true>(L + RING_OFF, g, T, E); }
            }
            SEAM(pb + 0);
        }
        if (KIND(4) && IN(pb + 1)) {
            KArgs ap = kargs(); PHASE_IDS;
            for (int rep = 0; rep < NREP(4); ++rep) {
            attn_phase(WSP(bf16, WS_Z), WSP(bf16, WS_O), ap->in[13] + l * 8, ap->in[11] + l * 128, ap->in[12] + l * 128, (char*)lds + RING_OFF, bx, G);
            }
            SEAM(pb + 1);
        }
        if (KIND(5) && IN(pb + 2)) {
            KArgs ap = kargs(); PHASE_IDS;
            for (int rep = 0; rep < NREP(5); ++rep) {
            pg8::Gemm g{WSP(bf16, WS_O), WSP(bf16, WS_WT) + (size_t)l * LAYER_W + W_BR, NTOK, DM, DM}; pg8::StaticOrder S; S.init(NTOK, DM, G, bx);
            pg8::EpiMerge E{WSP(bf16, WS_MG), DM, 1024 / pg8::BK, WSP(bf16, WS_Z), INW, Z_GA, Z_GB};
            pg8::gemm_phase<pg8::EpiMerge, pg8::StaticOrder, true, true>(L + RING_OFF, g, S, E);
            }
            SEAM(pb + 2);
        }
        if (KIND(6) && IN(pb + 3)) {
            KArgs ap = kargs(); PHASE_IDS;
            for (int rep = 0; rep < NREP(6); ++rep) {
            pg8::Gemm g{WSP(bf16, WS_MG), WSP(bf16, WS_WT) + (size_t)l * LAYER_W + W_OUT, NTOK, DM, DM}; pg8::StaticOrder S; S.init(NTOK, DM, G, bx);
            pg8::EpiPlain E{WSP(bf16, WS_O), DM};
            pg8::gemm_phase<pg8::EpiPlain, pg8::StaticOrder, true, true>(L + RING_OFF, g, S, E);
            }
            SEAM(pb + 3);
        }
        if (KIND(7) && IN(pb + 4)) {
            KArgs ap = kargs(); PHASE_IDS; const float* modl = WSP(float, WS_MOD) + (size_t)l * NBATCH * NMOD;
            norm_phase<1, true>(nullptr, nullptr, WSP(bf16, WS_X), nullptr, WSP(bf16, WS_O), WSP(bf16, WS_U), ap->in[5] + l * DM, modl + 2 * DM, ap->in[6] + l * DM, modl + 4 * DM, modl + 3 * DM, gw, ngw, lane);
            SEAM(pb + 4);
        }
        if (KIND(8) && IN(pb + 5)) {
            KArgs ap = kargs(); PHASE_IDS;
            for (int rep = 0; rep < NREP(8); ++rep) {
            pg8::Gemm g{WSP(bf16, WS_U), WSP(bf16, WS_WT) + (size_t)l * LAYER_W + W_13, NTOK, 2 * DFF, DM}; pg8::StaticOrder S; S.init(NTOK, 2 * DFF, G, bx); S.split_tail();
            pg8::EpiSwiglu E{WSP(bf16, WS_Z), DFF};
            pg8::gemm_phase<pg8::EpiSwiglu, pg8::StaticOrder, true, true>(L + RING_OFF, g, S, E);
            { pg8::TailOrder T{S}; pg8::gemm_phase<pg8::EpiSwiglu, pg8::TailOrder, true, true, false, true>(L + RING_OFF, g, T, E); }
            }
            SEAM(pb + 5);
        }
        if (KIND(9) && IN(pb + 6)) {
            KArgs ap = kargs(); PHASE_IDS;
            for (int rep = 0; rep < NREP(9); ++rep) {
            pg8::Gemm g{WSP(bf16, WS_Z), WSP(bf16, WS_WT) + (size_t)l * LAYER_W + W_2, NTOK, DM, DFF}; pg8::StaticOrder S; S.init(NTOK, DM, G, bx);
            pg8::EpiPlain E{WSP(bf16, WS_O), DM};
            pg8::gemm_phase<pg8::EpiPlain, pg8::StaticOrder, true, true, true>(L + RING_OFF, g, S, E);
            }
            SEAM(pb + 6);
        }
        if (KIND(10) && IN(pb + 7)) {
            KArgs ap = kargs(); PHASE_IDS; const float* modl = WSP(float, WS_MOD) + (size_t)l * NBATCH * NMOD;
            if (l + 1 < DEPTH) { const float* modn = modl + (size_t)NBATCH * NMOD;
                norm_phase<1, true>(nullptr, nullptr, WSP(bf16, WS_X), nullptr, WSP(bf16, WS_O), WSP(bf16, WS_U), ap->in[7] + l * DM, modl + 5 * DM, ap->in[4] + (l + 1) * DM, modn + 1 * DM, modn + 0 * DM, gw, ngw, lane); }
            else norm_phase<1, false>(nullptr, nullptr, WSP(bf16, WS_X), ap->out, WSP(bf16, WS_O), nullptr, ap->in[7] + l * DM, modl + 5 * DM, nullptr, nullptr, nullptr, gw, ngw, lane);
            SEAM(pb + 7);
        }
    }
#undef IN
#undef SEAM
#undef WSP
#undef PHASE_IDS
}

extern "C" void kernel_launch(void* const* d_in, const int* in_sizes, int n_in, void* d_out, int out_size, void* d_ws, size_t ws_size, hipStream_t stream) {
    static int grid = 0;
    if (grid == 0) {
        if (n_in != 19 || out_size != NTOK * DM || ws_size < WS_END) { fprintf(stderr, "kernel_launch: unexpected shapes (n_in %d out %d ws %zu, need ws >= %zu); nothing launched\n", n_in, out_size, ws_size, (size_t)WS_END); grid = -1; return; }
        int dev = 0, cus = 0, per_cu = 0;
        if (hipGetDevice(&dev) != hipSuccess || hipDeviceGetAttribute(&cus, hipDeviceAttributeMultiprocessorCount, dev) != hipSuccess) { grid = -1; return; }
        if (hipFuncSetAttribute((const void*)mk_fwd, hipFuncAttributeMaxDynamicSharedMemorySize, LDS_BYTES) != hipSuccess) { fprintf(stderr, "kernel_launch: hipFuncSetAttribute failed\n"); grid = -1; return; }
        if (hipOccupancyMaxActiveBlocksPerMultiprocessor(&per_cu, (const void*)mk_fwd, NWAVES * 64, LDS_BYTES) != hipSuccess || per_cu < 1) { fprintf(stderr, "kernel_launch: occupancy query says %d blocks per CU\n", per_cu); }
        (void)hipGetLastError();
        grid = cus;
    }
    if (grid < 0) return;
    if (hipMemsetAsync((char*)d_ws + WS_CTL, 0, CTL_ZERO_BYTES, stream) != hipSuccess) return;
    Args a{};
    for (int i = 0; i < 19; ++i) a.in[i] = (const float*)d_in[i];
    a.out = (float*)d_out; a.ws = (unsigned char*)d_ws;
#if MK_LAUNCH_MODE == 1
    a.ph_lo = 0; a.ph_hi = N_PHASES; a.li = 0; a.pad = 0;
    hipLaunchKernelGGL(mk_fwd, dim3(grid), dim3(NWAVES * 64), LDS_BYTES, stream, a);
#else
    for (int p = 0; p < N_PHASES; ++p) { a.ph_lo = p; a.ph_hi = p + 1; a.li = 0; a.pad = 0;
        hipLaunchKernelGGL(mk_fwd, dim3(grid), dim3(NWAVES * 64), LDS_BYTES, stream, a); }
#endif
    const hipError_t le = hipPeekAtLastError();
    if (le != hipSuccess) fprintf(stderr, "kernel_launch: launch failed: %s\n", hipGetErrorName(le));
}
```

```cpp
#include <hip/hip_runtime.h>
#include <cstdio>
#include <cstdint>
namespace pg8 {
#define PG8_LAS __attribute__((address_space(3)))
typedef unsigned short bf16_t;
typedef short bf16x8 __attribute__((ext_vector_type(8)));
typedef float f32x4 __attribute__((ext_vector_type(4)));
typedef unsigned u32x4 __attribute__((ext_vector_type(4)));
constexpr int BM = 256, BK = 64, HALF = 128, HTB = HALF * BK * 2  , STAGE_BYTES = 8 * HTB, NXCD = 8, WGM = 4;

__host__ __device__ __forceinline__ int lds_byte(int r, int c) { const int st = (r >> 4) * 2 + (c >> 5), rr = r & 15, cc = c & 31, ob = rr * 64 + cc * 2; return st * 1024 + (ob ^ (((ob >> 9) & 1) << 5)); }
__host__ __device__ __forceinline__ void stage_rc(int b, int& R, int& C) { const int st = b / 1024, sb = b % 1024, swz = sb ^ (((sb >> 9) & 1) << 5); R = (st >> 1) * 16 + swz / 64; C = (st & 1) * 32 + (swz % 64) / 2; }
__host__ __device__ __forceinline__ int perm32(int rho) { const int n = rho >> 4, i = rho & 15; return 8 * (i >> 2) + 4 * n + (i & 3); }

struct Unit { int pm, pn, hf; };
struct Gemm { const bf16_t* A; const bf16_t* Bt; int M, N, K; };

struct StaticOrder {
    int nM, nN, nwg, G, c, lim;
    __host__ __device__ void init(int M, int N, int G_, int c_) { nM = M / BM; nN = N / BM; nwg = nM * nN; G = G_; c = c_; lim = nwg; }
    __host__ __device__ void split_tail() { const int full = (nwg / G) * G; if (2 * (nwg - full) <= G) lim = full; }
    __host__ __device__ void map(int wgid, Unit& u) const {
        { const int q = nwg / NXCD, r = nwg % NXCD, xcd = wgid % NXCD, off = wgid / NXCD; wgid = (xcd < r ? xcd * (q + 1) : r * (q + 1) + (xcd - r) * q) + off; }
        const int nig = WGM * nN, gid = wgid / nig, fm = gid * WGM, gsz = (nM - fm) < WGM ? (nM - fm) : WGM;
        u.pm = fm + ((wgid % nig) % gsz); u.pn = (wgid % nig) / gsz; u.hf = 0;
    }
    __host__ __device__ bool next(int i, Unit& u) const { const long L = (long)i * G + c; if (L >= lim) return false; map((int)L, u); return true; }
    __device__ __forceinline__ void a_ready(const Unit&) const {}
    __device__ __forceinline__ void done(const Unit&) const {}
};
struct TailOrder {
    StaticOrder S;
    __host__ __device__ bool next(int i, Unit& u) const { const int L = S.lim + (S.c >> 1); if (i > 0 || L >= S.nwg) return false; S.map(L, u); u.hf = S.c & 1; return true; }
    __device__ __forceinline__ void a_ready(const Unit&) const {}
    __device__ __forceinline__ void done(const Unit&) const {}
};
typedef float f32x2_t __attribute__((ext_vector_type(2))); typedef __bf16 bf16x2_t __attribute__((ext_vector_type(2)));
__device__ __forceinline__ unsigned cvt_pk_bf16(float lo, float hi) { f32x2_t v = {lo, hi}; bf16x2_t b = __builtin_convertvector(v, bf16x2_t); return __builtin_bit_cast(unsigned, b); }
typedef float f32x2 __attribute__((ext_vector_type(2)));
typedef unsigned u32x2 __attribute__((ext_vector_type(2)));
__device__ __forceinline__ float bf_lo(unsigned w) { return __uint_as_float(w << 16); }
__device__ __forceinline__ float bf_hi(unsigned w) { return __uint_as_float(w & 0xffff0000u); }
__device__ __forceinline__ float sigmoid_f(float x) { return __builtin_amdgcn_rcpf(1.0f + __builtin_amdgcn_exp2f(x * -1.4426950408889634f)); }
__device__ __forceinline__ u32x4 pack8(const f32x4 v0, const f32x4 v1) { u32x4 w; w.x = cvt_pk_bf16(v0[0], v0[1]); w.y = cvt_pk_bf16(v0[2], v0[3]); w.z = cvt_pk_bf16(v1[0], v1[1]); w.w = cvt_pk_bf16(v1[2], v1[3]); return w; }
__device__ __forceinline__ void unpack8(const u32x4 w, f32x4& v0, f32x4& v1) { v0 = (f32x4){bf_lo(w.x), bf_hi(w.x), bf_lo(w.y), bf_hi(w.y)}; v1 = (f32x4){bf_lo(w.z), bf_hi(w.z), bf_lo(w.w), bf_hi(w.w)}; }

template <bool NT> __device__ __forceinline__ void st16(bf16_t* p, const u32x4 v) { if (NT) __builtin_nontemporal_store(v, (u32x4*)p); else *(u32x4*)p = v; }
__device__ __forceinline__ unsigned dpp_ror8(unsigned v) { return (unsigned)__builtin_amdgcn_update_dpp(0, (int)v, 0x128  , 0xf, 0xf, false); }
struct EpiPlain {
    static constexpr bool PERM = true, AFTER_DRAIN = false, HAS_MID = false;
    bf16_t* O; int ldc;
    __device__ __forceinline__ void operator()(const f32x4 (&acc)[2][2][4][2], const Unit& u, int wr, int wc, int fr, int fq) const {
        const bool low = fr < 8;
        const int row0 = u.pm * BM + wr * 64 + (fr & 7), colp = u.pn * BM + wc * 64 + (low ? 0 : 32) + 8 * fq;
#pragma unroll
        for (int ai = 0; ai < 2; ++ai)
#pragma unroll
            for (int m = 0; m < 4; ++m) { bf16_t* rowp = O + (size_t)(row0 + ai * HALF + m * 16) * ldc + colp;
                const u32x4 X = pack8(acc[ai][0][m][0], acc[ai][0][m][1]), Y = pack8(acc[ai][1][m][0], acc[ai][1][m][1]);
                u32x4 S = low ? Y : X, R; R.x = dpp_ror8(S.x); R.y = dpp_ror8(S.y); R.z = dpp_ror8(S.z); R.w = dpp_ror8(S.w);
                *(u32x4*)rowp = low ? X : R;
                *(u32x4*)(rowp + (size_t)8 * ldc) = low ? R : Y; }
    }
};
#ifndef MK_NT_Z
#define MK_NT_Z false
#endif
struct EpiZ {
    static constexpr bool PERM = true, AFTER_DRAIN = false, HAS_MID = false;
    bf16_t* O; int ldc; const float* tab; const float* qn; const float* kn; PG8_LAS float* P;
    static constexpr int tab_cos1 = 0, tab_sin1 = 8192 * 64, tab_cr = 2 * 8192 * 64, tab_sr = tab_cr + 128 * 32, tab_cc = tab_sr + 128 * 32, tab_sc = tab_cc + 64 * 32;
    __device__ __forceinline__ void operator()(const f32x4 (&acc)[2][2][4][2], const Unit& u, int wr, int wc, int fr, int fq) const { body<2>(acc, u, 0, wr, wc, fr, fq); }
    __device__ __forceinline__ void half(const f32x4 (&acc)[2][2][4][2], const Unit& u, int wr, int wc, int fr, int fq) const { body<1>(acc, u, u.hf * HALF, wr, wc, fr, fq); }
    template <int NAI> __device__ __forceinline__ void body(const f32x4 (&acc)[2][2][4][2], const Unit& u, const int rofs, int wr, int wc, int fr, int fq) const {
        asm volatile("" : "+v"(fr), "+v"(fq));
        const int row0 = u.pm * BM + rofs + wr * 64 + fr, col0 = u.pn * BM + wc * 32 + 8 * fq;
        const int kind = (u.pn <= 4) ? 1 : ((u.pn >= 6 && u.pn <= 10) ? 2 : 0);
        if (kind == 0) {
            if (u.pn >= 12) {
                const int cg = (u.pn - 12) * 4 + wc;
                const size_t gbase = (size_t)((u.pm * 16 + (rofs >> 4) + wr * 4) * 16 + (cg >> 3)) * ldc + 3072 + (cg & 7) * 512 + (fq * 16 + fr) * 8;
#pragma unroll
                for (int ai = 0; ai < NAI; ++ai)
#pragma unroll
                    for (int m = 0; m < 4; ++m) { bf16_t* rowp = O + gbase + (size_t)((ai * 8 + m) * 16) * ldc;
                        f32x4 r0, r1, s0, s1;
#pragma unroll
                        for (int j = 0; j < 4; ++j) {
                            const float ea0 = __builtin_amdgcn_exp2f(__builtin_amdgcn_fmed3f(acc[ai][0][m][0][j], -60.f, 60.f)), ea1 = __builtin_amdgcn_exp2f(__builtin_amdgcn_fmed3f(acc[ai][0][m][1][j], -60.f, 60.f));
                            const float eb0 = __builtin_amdgcn_exp2f(__builtin_amdgcn_fmed3f(acc[ai][1][m][0][j], -60.f, 60.f)), eb1 = __builtin_amdgcn_exp2f(__builtin_amdgcn_fmed3f(acc[ai][1][m][1][j], -60.f, 60.f));
                            r0[j] = (1.0f + eb0) * __builtin_amdgcn_rcpf(1.0f + ea0); r1[j] = (1.0f + eb1) * __builtin_amdgcn_rcpf(1.0f + ea1);
                            s0[j] = __builtin_amdgcn_rcpf(1.0f + eb0); s1[j] = __builtin_amdgcn_rcpf(1.0f + eb1); }
                        st16<MK_NT_Z>(rowp, pack8(r0, r1)); st16<MK_NT_Z>(rowp + (size_t)8 * ldc, pack8(s0, s1)); }
                return;
            }
#pragma unroll
            for (int ai = 0; ai < NAI; ++ai)
#pragma unroll
                for (int m = 0; m < 4; ++m) { bf16_t* rowp = O + (size_t)(row0 + ai * HALF + m * 16) * ldc + col0;
#pragma unroll
                    for (int bj = 0; bj < 2; ++bj) st16<MK_NT_Z>(rowp + bj * HALF, pack8(acc[ai][bj][m][0], acc[ai][bj][m][1])); }
            return;
        }
        const int g = 4 * wc + fq;
        const int prow0 = u.pm * BM;
        const int pos0 = (prow0 < 8192 ? prow0 : ((prow0 - 8192) & 4095)) + rofs + wr * 64 + fr;
        if (kind == 1) {
            f32x4 cc[2][4], sn[2][4];
#pragma unroll
            for (int ai = 0; ai < NAI; ++ai)
#pragma unroll
                for (int m = 0; m < 4; ++m) { const int pos = pos0 + ai * HALF + m * 16; const int ix = (((pos >> 4) * 16 + g) * 16 + (pos & 15)) * 4; cc[ai][m] = *(const f32x4*)(tab + tab_cos1 + ix); sn[ai][m] = *(const f32x4*)(tab + tab_sin1 + ix); }
#pragma unroll
            for (int ai = 0; ai < NAI; ++ai)
#pragma unroll
                for (int m = 0; m < 4; ++m) { bf16_t* rowp = O + (size_t)(row0 + ai * HALF + m * 16) * ldc + col0; const f32x4 c = cc[ai][m], s = sn[ai][m];
#pragma unroll
                    for (int bj = 0; bj < 2; ++bj) { const f32x4 v0 = acc[ai][bj][m][0], v1 = acc[ai][bj][m][1];
                        st16<MK_NT_Z>(rowp + bj * HALF, pack8(v0 * c - v1 * s, v1 * c + v0 * s)); } }
            return;
        }
        float ss[2][4][2];
#pragma unroll
        for (int ai = 0; ai < NAI; ++ai)
#pragma unroll
            for (int m = 0; m < 4; ++m)
#pragma unroll
                for (int bj = 0; bj < 2; ++bj) { const f32x4 a = acc[ai][bj][m][0], b = acc[ai][bj][m][1];
                    float t = (a[0] * a[0] + a[1] * a[1]) + (a[2] * a[2] + a[3] * a[3]) + (b[0] * b[0] + b[1] * b[1]) + (b[2] * b[2] + b[3] * b[3]);
                    t += __shfl_xor(t, 16); t += __shfl_xor(t, 32); ss[ai][m][bj] = t;
                    if (fq == 0) P[((ai * HALF + wr * 64 + m * 16 + fr) * 2 + bj) * 4 + wc] = t; }
        asm volatile("s_waitcnt lgkmcnt(0)" ::: "memory"); __builtin_amdgcn_s_barrier(); asm volatile("" ::: "memory");
        const float* gn = (u.pn == 10) ? kn : qn; const float kmul = (u.pn == 10) ? 0.12751743082459868f : 1.0f;
        const int gg = g & 7, n0 = (g < 8) ? 4 * g : 64 + 4 * gg;
        const f32x4 g0 = *(const f32x4*)(gn + n0), g1 = *(const f32x4*)(gn + n0 + 32);
#pragma unroll
        for (int ai = 0; ai < NAI; ++ai)
#pragma unroll
            for (int m = 0; m < 4; ++m) { const int pos = pos0 + ai * HALF + m * 16; bf16_t* rowp = O + (size_t)(row0 + ai * HALF + m * 16) * ldc + col0;
                const int toff = (g < 8) ? (pos >> 6) * 32 + 4 * gg : ((((pos & 63) >> 4) * 8 + gg) * 16 + (pos & 15)) * 4;
                const f32x4 c = *(const f32x4*)(tab + ((g < 8) ? tab_cr : tab_cc) + toff), s = *(const f32x4*)(tab + ((g < 8) ? tab_sr : tab_sc) + toff);
#pragma unroll
                for (int bj = 0; bj < 2; ++bj) { const f32x4 pp = *(const PG8_LAS f32x4*)(P + ((ai * HALF + wr * 64 + m * 16 + fr) * 2 + bj) * 4);
                    const float rstd = __builtin_amdgcn_rsqf(((pp[0] + pp[1]) + (pp[2] + pp[3])) * (1.0f / 128.0f) + 1e-6f) * kmul;
                    const f32x4 v0 = acc[ai][bj][m][0] * g0 * rstd, v1 = acc[ai][bj][m][1] * g1 * rstd;
                    st16<MK_NT_Z>(rowp + bj * HALF, pack8(v0 * c - v1 * s, v1 * c + v0 * s)); } }
    }
};
struct EpiSwiglu {
    static constexpr bool PERM = true, AFTER_DRAIN = false, HAS_MID = false;
    bf16_t* O; int ldc;
    __device__ __forceinline__ void operator()(const f32x4 (&acc)[2][2][4][2], const Unit& u, int wr, int wc, int fr, int fq) const { body<2>(acc, u, 0, wr, wc, fr, fq); }
    __device__ __forceinline__ void half(const f32x4 (&acc)[2][2][4][2], const Unit& u, int wr, int wc, int fr, int fq) const { body<1>(acc, u, u.hf * 8, wr, wc, fr, fq); }
    template <int NAI> __device__ __forceinline__ void body(const f32x4 (&acc)[2][2][4][2], const Unit& u, const int r16, int wr, int wc, int fr, int fq) const {
        const size_t base = (size_t)(u.pm * 16 + r16 + wr * 4) * 16 * ldc + (size_t)(u.pn * 4 + wc) * 512 + (fr & 7) * 64 + (fr >> 3) * 32 + 8 * fq;
#pragma unroll
        for (int ai = 0; ai < NAI; ++ai)
#pragma unroll
            for (int m = 0; m < 4; ++m) { bf16_t* p = O + base + (size_t)(ai * 8 + m) * 16 * ldc;
                f32x4 h[2];
#pragma unroll
                for (int n = 0; n < 2; ++n) { const f32x4 a = acc[ai][0][m][n], b = acc[ai][1][m][n];
#pragma unroll
                    for (int j = 0; j < 4; ++j) h[n][j] = a[j] * b[j] * __builtin_amdgcn_rcpf(1.0f + __builtin_amdgcn_exp2f(a[j])); }
                st16<MK_NT_Z>(p, pack8(h[0], h[1])); }
    }
};
struct EpiMerge {
    static constexpr bool PERM = true, AFTER_DRAIN = false, HAS_MID = true;
    bf16_t* O; int ldc; int mid_t; const bf16_t* Z; int ldz; int ga_off, gb_off;
    __device__ __forceinline__ void mid(f32x4 (&acc)[2][2][4][2], const Unit& u, int wr, int wc, int fr, int fq) const {
        int lane8 = (fq * 16 + fr) * 8;
        asm volatile("" : "+v"(lane8));
        u32x4 wa[2][4][2];
        const size_t gb0 = (size_t)((u.pm * 16 + wr * 4) * 16 + u.pn) * ldz + ga_off + wc * 512 + lane8;
#pragma unroll
        for (int ai = 0; ai < 2; ++ai)
#pragma unroll
            for (int m = 0; m < 4; ++m) { const bf16_t* zr = Z + gb0 + (size_t)((ai * 8 + m) * 16) * ldz;
#pragma unroll
                for (int bj = 0; bj < 2; ++bj) wa[ai][m][bj] = *(const u32x4*)(zr + bj * 2048); }
#pragma unroll
        for (int ai = 0; ai < 2; ++ai)
#pragma unroll
            for (int m = 0; m < 4; ++m)
#pragma unroll
                for (int bj = 0; bj < 2; ++bj) { f32x4 a0, a1; unpack8(wa[ai][m][bj], a0, a1); acc[ai][bj][m][0] *= a0; acc[ai][bj][m][1] *= a1; }
    }
    __device__ __forceinline__ void operator()(const f32x4 (&acc)[2][2][4][2], const Unit& u, int wr, int wc, int fr, int fq) const {
        const int row0 = u.pm * BM + wr * 64 + fr, col0 = u.pn * BM + wc * 32 + 8 * fq;
        u32x4 wb[2][4][2];
#pragma unroll
        for (int ai = 0; ai < 2; ++ai)
#pragma unroll
            for (int m = 0; m < 4; ++m) { const bf16_t* zr = Z + (size_t)((u.pm * 16 + wr * 4 + ai * 8 + m) * 16 + u.pn + 8) * ldz + ga_off + wc * 512 + (fq * 16 + fr) * 8;
#pragma unroll
                for (int bj = 0; bj < 2; ++bj) wb[ai][m][bj] = *(const u32x4*)(zr + bj * 2048); }
#pragma unroll
        for (int ai = 0; ai < 2; ++ai)
#pragma unroll
            for (int m = 0; m < 4; ++m) { bf16_t* rowp = O + (size_t)(row0 + ai * HALF + m * 16) * ldc + col0;
#pragma unroll
                for (int bj = 0; bj < 2; ++bj) { f32x4 b0, b1; unpack8(wb[ai][m][bj], b0, b1);
                    *(u32x4*)(rowp + bj * HALF) = pack8(acc[ai][bj][m][0] * b0, acc[ai][bj][m][1] * b1); } }
    }
};

template <class Epi, class Sched, bool ALIGN_EPI = false, bool SP2 = false, bool ABL = false, bool HU = false>
__device__ __forceinline__ void gemm_phase(PG8_LAS unsigned char* lds, const Gemm g, const Sched& S, const Epi& E) {
    int tid = threadIdx.x; asm volatile("" : "+v"(tid));
    const int wid = __builtin_amdgcn_readfirstlane(tid >> 6), lane = tid & 63, wr = wid >> 2, wc = wid & 3, fr = lane & 15, fq = lane >> 4;
    const int K = g.K, nt = K / BK;
    unsigned voffA[2], voffB[2];
#pragma unroll
    for (int i = 0; i < 2; ++i) { int R, C; stage_rc(tid * 16 + i * 8192, R, C); const int Rb = Epi::PERM ? ((R & ~31) + perm32(R & 31)) : R;
        voffA[i] = ABL ? (unsigned)((R >> 4) * (16 * K) + (C >> 5) * 512 + (R & 7) * 64 + ((R >> 3) & 1) * 32 + (C & 31)) * 2u : (unsigned)(R * K + C) * 2u; voffB[i] = (unsigned)(Rb * K + C) * 2u; }
    const size_t kstep = (size_t)(BK * 2);
    const size_t kstepA = ABL ? (size_t)(BK / 32) * 1024 : kstep;
    const size_t hstep = (size_t)HALF * K * 2;
    unsigned voffA1[2] = {HU ? 0u : voffA[0], HU ? 0u : voffA[1]};
    const size_t hstepA = HU ? 0 : hstep; static_assert(!HU || (SP2 && !ABL && !Epi::HAS_MID), "HALF units: SP2 schedule, row-major A, no mid hook");
    const size_t tstep = 2 * hstep;
    const unsigned ldsw = (unsigned)wid * 1024u;
    const int aoff = lds_byte(wr * 64 + fr, fq * 8), boff = lds_byte(wc * 32 + fr, fq * 8);
#define PG8_SA(b, h) (((b) * 2 + (h)) * HTB)
#define PG8_SB(b, h) ((4 + (b) * 2 + (h)) * HTB)
#define PG8_STAGE(bufoff, gbase, voff) do { _Pragma("unroll") for (int _i = 0; _i < 2; ++_i) \
        __builtin_amdgcn_global_load_lds((const unsigned*)((const char*)(gbase) + (voff)[_i]), (PG8_LAS unsigned*)(lds + (bufoff) + ldsw + _i * 8192), 16, 0, 0); } while (0)
#define PG8_LDA(dst, b, h) do { _Pragma("unroll") for (int m = 0; m < 4; ++m) _Pragma("unroll") for (int k = 0; k < 2; ++k) dst[m][k] = *(const PG8_LAS bf16x8*)(lds + PG8_SA(b, h) + aoff + m * 2048 + k * 1024); } while (0)
#define PG8_LDB(dst, b, h) do { _Pragma("unroll") for (int n = 0; n < 2; ++n) _Pragma("unroll") for (int k = 0; k < 2; ++k) dst[n][k] = *(const PG8_LAS bf16x8*)(lds + PG8_SB(b, h) + boff + n * 2048 + k * 1024); } while (0)
#define PG8_MMA(ai, bj, At, Bt) do { __builtin_amdgcn_s_setprio(1); _Pragma("unroll") for (int m = 0; m < 4; ++m) _Pragma("unroll") for (int n = 0; n < 2; ++n) _Pragma("unroll") for (int k = 0; k < 2; ++k) \
        acc[ai][bj][m][n] = __builtin_amdgcn_mfma_f32_16x16x32_bf16(Bt[n][k], At[m][k], acc[ai][bj][m][n], 0, 0, 0); __builtin_amdgcn_s_setprio(0); } while (0)
#define PG8_WAIT_V(n) asm volatile("s_waitcnt vmcnt(" #n ")" ::: "memory")
#define PG8_WAIT_L(n) asm volatile("s_waitcnt lgkmcnt(" #n ")" ::: "memory")
#define PG8_BAR __builtin_amdgcn_s_barrier()
#define PG8_SCHED __builtin_amdgcn_sched_barrier(0)
    Unit cur, nxt; int ui = 0;
    if (!S.next(0, cur)) return;
    f32x4 acc[2][2][4][2];
#pragma unroll
    for (int a = 0; a < 2; ++a)
#pragma unroll
        for (int b = 0; b < 2; ++b)
#pragma unroll
            for (int m = 0; m < 4; ++m)
#pragma unroll
                for (int n = 0; n < 2; ++n) acc[a][b][m][n] = (f32x4){0.f, 0.f, 0.f, 0.f};
    bf16x8 At[4][2], B0[2][2], B1[2][2];
    const char* cA = (const char*)g.A + (size_t)cur.pm * tstep + (HU ? (size_t)cur.hf * hstep : 0); const char* cB = (const char*)g.Bt + (size_t)cur.pn * tstep;
    S.a_ready(cur);
    if constexpr (SP2) {
        PG8_STAGE(PG8_SB(0, 0), cB, voffB); PG8_STAGE(PG8_SB(0, 1), cB + hstep, voffB); PG8_STAGE(PG8_SA(0, 0), cA, voffA); PG8_STAGE(PG8_SA(0, 1), cA + hstepA, voffA1);
        if (wr == 1) PG8_BAR;
        PG8_WAIT_V(2); PG8_BAR;
        PG8_STAGE(PG8_SB(1, 0), cB + kstep, voffB); PG8_STAGE(PG8_SA(1, 0), cA + kstepA, voffA); PG8_STAGE(PG8_SB(1, 1), cB + hstep + kstep, voffB);
        PG8_WAIT_V(6); PG8_BAR;
    } else {
        PG8_STAGE(PG8_SB(0, 0), cB, voffB); PG8_STAGE(PG8_SA(0, 0), cA, voffA); PG8_STAGE(PG8_SB(0, 1), cB + hstep, voffB); PG8_STAGE(PG8_SA(0, 1), cA + hstep, voffA);
        if (wr == 1) PG8_BAR;
        PG8_WAIT_V(4); PG8_BAR;
        PG8_STAGE(PG8_SB(1, 0), cB + kstep, voffB); PG8_STAGE(PG8_SA(1, 0), cA + kstepA, voffA); PG8_STAGE(PG8_SB(1, 1), cB + hstep + kstep, voffB);
        PG8_WAIT_V(6); PG8_BAR;
    }
    for (;;) {
        const bool has_next = S.next(ui + 1, nxt);
        const char* nA = has_next ? (const char*)g.A + (size_t)nxt.pm * tstep + (HU ? (size_t)nxt.hf * hstep : 0) : cA; const char* nB = has_next ? (const char*)g.Bt + (size_t)nxt.pn * tstep : cB;
        for (int t = 0; t < nt; t += 2) {
            const bool last = (t == nt - 2);
            if constexpr (Epi::HAS_MID) { if (t == E.mid_t) E.mid(acc, cur, wr, wc, fr, fq); }
            const char* a1 = cA + (size_t)(t + 1) * kstepA;
            const char* a2 = last ? nA : cA + (size_t)(t + 2) * kstepA; const char* b2 = last ? nB : cB + (size_t)(t + 2) * kstep;
            const char* a3 = a2 + kstepA; const char* b3 = b2 + kstep;
            if (last && has_next) S.a_ready(nxt);
            if constexpr (SP2) {
            PG8_LDB(B0, 0, 0); PG8_LDB(B1, 0, 1); PG8_SCHED; PG8_LDA(At, 0, 0); PG8_STAGE(PG8_SA(1, 1), a1 + hstepA, voffA1);
            PG8_WAIT_V(8); PG8_WAIT_L(0); PG8_BAR; PG8_MMA(0, 0, At, B0); PG8_MMA(0, 1, At, B1); PG8_BAR; PG8_SCHED;
            if constexpr (!HU) PG8_LDA(At, 0, 1); PG8_STAGE(PG8_SB(0, 0), b2, voffB); PG8_STAGE(PG8_SB(0, 1), b2 + hstep, voffB); PG8_STAGE(PG8_SA(0, 0), a2, voffA);
            PG8_WAIT_V(8); PG8_WAIT_L(0); PG8_BAR; if constexpr (!HU) { PG8_MMA(1, 0, At, B0); PG8_MMA(1, 1, At, B1); } PG8_BAR; PG8_SCHED;
            PG8_LDB(B0, 1, 0); PG8_LDB(B1, 1, 1); PG8_SCHED; PG8_LDA(At, 1, 0); PG8_STAGE(PG8_SA(0, 1), a2 + hstepA, voffA1);
            PG8_WAIT_V(8); PG8_WAIT_L(0); PG8_BAR; PG8_MMA(0, 0, At, B0); PG8_MMA(0, 1, At, B1); PG8_BAR; PG8_SCHED;
            if constexpr (!HU) PG8_LDA(At, 1, 1); PG8_STAGE(PG8_SB(1, 0), b3, voffB); PG8_STAGE(PG8_SB(1, 1), b3 + hstep, voffB); PG8_STAGE(PG8_SA(1, 0), a3, voffA);
            PG8_WAIT_V(8); PG8_WAIT_L(0); PG8_BAR; if constexpr (!HU) { PG8_MMA(1, 0, At, B0); PG8_MMA(1, 1, At, B1); } PG8_BAR; PG8_SCHED;
            } else {
            PG8_LDB(B0, 0, 0); PG8_SCHED; PG8_LDA(At, 0, 0); PG8_STAGE(PG8_SA(1, 1), a1 + hstep, voffA);
            PG8_WAIT_L(8); PG8_BAR; PG8_WAIT_L(0); PG8_MMA(0, 0, At, B0); PG8_BAR; PG8_SCHED;
            PG8_LDB(B1, 0, 1); PG8_STAGE(PG8_SB(0, 0), b2, voffB);
            PG8_BAR; PG8_WAIT_L(0); PG8_MMA(0, 1, At, B1); PG8_BAR;
            PG8_LDA(At, 0, 1); PG8_STAGE(PG8_SA(0, 0), a2, voffA);
            PG8_BAR; PG8_WAIT_L(0); PG8_MMA(1, 0, At, B0); PG8_BAR; PG8_SCHED;
            PG8_STAGE(PG8_SB(0, 1), b2 + hstep, voffB);
            PG8_WAIT_V(6); PG8_BAR; PG8_MMA(1, 1, At, B1); PG8_BAR;
            PG8_LDB(B0, 1, 0); PG8_SCHED; PG8_LDA(At, 1, 0); PG8_STAGE(PG8_SA(0, 1), a2 + hstep, voffA);
            PG8_WAIT_L(8); PG8_BAR; PG8_WAIT_L(0); PG8_MMA(0, 0, At, B0); PG8_BAR; PG8_SCHED;
            PG8_LDB(B1, 1, 1); PG8_STAGE(PG8_SB(1, 0), b3, voffB);
            PG8_BAR; PG8_WAIT_L(0); PG8_MMA(0, 1, At, B1); PG8_BAR;
            PG8_LDA(At, 1, 1); PG8_STAGE(PG8_SA(1, 0), a3, voffA);
            PG8_BAR; PG8_WAIT_L(0); PG8_MMA(1, 0, At, B0); PG8_BAR; PG8_SCHED;
            PG8_STAGE(PG8_SB(1, 1), b3 + hstep, voffB);
            PG8_WAIT_V(6); PG8_BAR; PG8_MMA(1, 1, At, B1); PG8_BAR;
            }
        }
        if constexpr (ALIGN_EPI) { if (wr == 0) PG8_BAR; }
        if constexpr (!Epi::AFTER_DRAIN) { if constexpr (HU) E.half(acc, cur, wr, wc, fr, fq); else E(acc, cur, wr, wc, fr, fq); S.done(cur); }
        if (!has_next) break;
#pragma unroll
        for (int a = 0; a < 2; ++a)
#pragma unroll
            for (int b = 0; b < 2; ++b)
#pragma unroll
                for (int m = 0; m < 4; ++m)
#pragma unroll
                    for (int n = 0; n < 2; ++n) acc[a][b][m][n] = (f32x4){0.f, 0.f, 0.f, 0.f};
        cur = nxt; cA = nA; cB = nB; ++ui;
        if constexpr (ALIGN_EPI) { if (wr == 1) PG8_BAR; }
    }
    PG8_WAIT_V(0);
    if constexpr (!ALIGN_EPI) { if (wr == 0) PG8_BAR; }
    PG8_BAR;
    if constexpr (Epi::AFTER_DRAIN) { E.fused(acc, cur, wr, wc, fr, fq, lds, wid, lane); S.done(cur); }
#undef PG8_SA
#undef PG8_SB
#undef PG8_STAGE
#undef PG8_LDA
#undef PG8_LDB
#undef PG8_MMA
#undef PG8_WAIT_V
#undef PG8_WAIT_L
#undef PG8_BAR
#undef PG8_SCHED
}
}
namespace att {
constexpr int   D = 128, NW = 8, QBLK = 32, KVBLK = 64;
constexpr float SCALE = 0.088388347648318440f;
constexpr float THR = 8.f;
constexpr int LDQ = 7168, LDK = 7168, LDO = 2048;
constexpr int SHM_V = KVBLK * D * 2, SHM_K = KVBLK * D * 2, SHM_ATTN = 2 * SHM_V + 2 * SHM_K + NW * 64 * 4;
typedef unsigned short bf16;
using bf16x8 = __attribute__((ext_vector_type(8))) short;
using s16x4  = __attribute__((ext_vector_type(4))) short;
using f32x16 = __attribute__((ext_vector_type(16))) float;
using u32x4  = __attribute__((ext_vector_type(4))) unsigned;
#define KSWZ(row, colB) ((row) * 256 + ((colB) ^ (((row) & 7) << 4)))
#define SBAR() __builtin_amdgcn_sched_barrier(0)
__device__ __forceinline__ int crow(int r, int hi) { return (r & 3) + 8 * (r >> 2) + 4 * hi; }
typedef float f32x2_t __attribute__((ext_vector_type(2))); typedef __bf16 bf16x2_t __attribute__((ext_vector_type(2)));
__device__ __forceinline__ unsigned cvtpk(float lo, float hi) { f32x2_t v = {lo, hi}; bf16x2_t b = __builtin_convertvector(v, bf16x2_t); return __builtin_bit_cast(unsigned, b); }

__device__ __forceinline__ void partialSM(f32x16& p0, f32x16& p1, float& m_reg, float& mn, float& alpha) {
  constexpr float C = SCALE * 1.4426950408889634f;
  float pmax = p0[0]; for (int r = 1; r < 16; ++r) pmax = fmaxf(pmax, p0[r]); for (int r = 0; r < 16; ++r) pmax = fmaxf(pmax, p1[r]);
  { auto rr = __builtin_amdgcn_permlane32_swap(__float_as_uint(pmax), __float_as_uint(pmax), false, false);
    pmax = fmaxf(__uint_as_float(rr[0]), __uint_as_float(rr[1])); }
  if (__builtin_expect(__all(pmax - m_reg <= THR / SCALE), 1)) { mn = m_reg; alpha = 1.f; }
  else { mn = fmaxf(m_reg, pmax); alpha = __builtin_amdgcn_exp2f((m_reg - mn) * C); m_reg = mn; }
  float mnC = -mn * C;
  for (int r = 0; r < 16; ++r) p0[r] = fmaf(p0[r], C, mnC); for (int r = 0; r < 16; ++r) p1[r] = fmaf(p1[r], C, mnC);
  for (int r = 0; r < 16; ++r) p0[r] = __builtin_amdgcn_exp2f(p0[r]);
}
__device__ __forceinline__ void partialSM_nomax(f32x16& p0) { for (int r = 0; r < 16; ++r) p0[r] = __builtin_amdgcn_exp2f(p0[r]); }
__device__ __forceinline__ void finishSM(f32x16& p0, f32x16& p1, float alpha, float& l_reg, bf16x8& pa0, bf16x8& pa1, bf16x8& pa2, bf16x8& pa3) {
  for (int r = 0; r < 16; ++r) p1[r] = __builtin_amdgcn_exp2f(p1[r]);
  float ps = 0; for (int r = 0; r < 16; ++r) ps += p0[r]; for (int r = 0; r < 16; ++r) ps += p1[r];
  { auto rr = __builtin_amdgcn_permlane32_swap(__float_as_uint(ps), __float_as_uint(ps), false, false);
    ps = __uint_as_float(rr[0]) + __uint_as_float(rr[1]); }
  l_reg = l_reg * alpha + ps;
#define PK4(P, BASE, OUT) do { unsigned a0 = cvtpk(P[BASE + 0], P[BASE + 1]), a1 = cvtpk(P[BASE + 2], P[BASE + 3]);   \
    unsigned b0 = cvtpk(P[BASE + 4], P[BASE + 5]), b1 = cvtpk(P[BASE + 6], P[BASE + 7]);                              \
    auto r0 = __builtin_amdgcn_permlane32_swap(a0, b0, false, false); auto r1 = __builtin_amdgcn_permlane32_swap(a1, b1, false, false); \
    u32x4 w = {r0[0], r1[0], r0[1], r1[1]}; OUT = *reinterpret_cast<bf16x8*>(&w); } while (0)
  PK4(p0, 0, pa0); PK4(p0, 8, pa1); PK4(p1, 0, pa2); PK4(p1, 8, pa3);
#undef PK4
}
__device__ __forceinline__ void qkt(f32x16& p0, f32x16& p1, const bf16* Ks, const bf16x8* qr, int r32, int hi, float init = 0.f) {
  for (int r = 0; r < 16; ++r) { p0[r] = init; p1[r] = init; }
  for (int d0 = 0; d0 < 8; ++d0) { int cb = (d0 * 16 + hi * 8) * 2;
    bf16x8 b0 = *reinterpret_cast<const bf16x8*>((const char*)Ks + KSWZ(r32, cb));
    bf16x8 b1 = *reinterpret_cast<const bf16x8*>((const char*)Ks + KSWZ(32 + r32, cb));
    p0 = __builtin_amdgcn_mfma_f32_32x32x16_bf16(b0, qr[d0], p0, 0, 0, 0);
    p1 = __builtin_amdgcn_mfma_f32_32x32x16_bf16(b1, qr[d0], p1, 0, 0, 0); }
}
__device__ __forceinline__ void wmask(f32x16& p0, f32x16& p1, int dk0, int hi) {
#pragma unroll
  for (int r = 0; r < 16; ++r) { const int d = dk0 + crow(r, hi); p0[r] = (d >= -128 && d <= 128) ? p0[r] : -1e30f; const int e = d + 32; p1[r] = (e >= -128 && e <= 128) ? p1[r] : -1e30f; }
}
__device__ __forceinline__ int v_st(int k, int c) { const int kk = (k & ~0xC) | ((k & 4) << 1) | ((k & 8) >> 1); return ((kk >> 3) * 4 + (c >> 5)) * 512 + ((kk & 7) * 32 + (c & 31)) * 2; }
__device__ __forceinline__ int v_rd_base(int lane) { return ((lane & 3) << 3) | (((lane >> 2) & 3) << 6) | (((lane >> 4) & 1) << 5) | (((lane >> 5) & 1) << 8); }
constexpr int v_rd_off(int d0, int ks, int half) { return d0 * 512 + ks * 4096 + half * 2048; }
template <int OFF> __device__ __forceinline__ s16x4 tr_read(int vb) {
  s16x4 r; asm volatile("ds_read_b64_tr_b16 %0, %1 offset:%2" : "=&v"(r) : "v"(vb), "i"(OFF) : "memory"); return r;
}
template <int D0> __device__ __forceinline__ void pv_one(f32x16& od, int vb, bf16x8 pa0, bf16x8 pa1, bf16x8 pa2, bf16x8 pa3) {
  const s16x4 l0 = tr_read<v_rd_off(D0, 0, 0)>(vb), h0 = tr_read<v_rd_off(D0, 0, 1)>(vb), l1 = tr_read<v_rd_off(D0, 1, 0)>(vb), h1 = tr_read<v_rd_off(D0, 1, 1)>(vb);
  const s16x4 l2 = tr_read<v_rd_off(D0, 2, 0)>(vb), h2 = tr_read<v_rd_off(D0, 2, 1)>(vb), l3 = tr_read<v_rd_off(D0, 3, 0)>(vb), h3 = tr_read<v_rd_off(D0, 3, 1)>(vb);
  asm volatile("s_waitcnt lgkmcnt(0)" ::: "memory"); SBAR();
#define PK(L, H) (bf16x8){L[0], L[1], L[2], L[3], H[0], H[1], H[2], H[3]}
  od = __builtin_amdgcn_mfma_f32_32x32x16_bf16(pa0, PK(l0, h0), od, 0, 0, 0);
  od = __builtin_amdgcn_mfma_f32_32x32x16_bf16(pa1, PK(l1, h1), od, 0, 0, 0);
  od = __builtin_amdgcn_mfma_f32_32x32x16_bf16(pa2, PK(l2, h2), od, 0, 0, 0);
  od = __builtin_amdgcn_mfma_f32_32x32x16_bf16(pa3, PK(l3, h3), od, 0, 0, 0);
#undef PK
}
__device__ __forceinline__ void pv_d0(f32x16* o, int vb, bf16x8 pa0, bf16x8 pa1, bf16x8 pa2, bf16x8 pa3) {
  pv_one<0>(o[0], vb, pa0, pa1, pa2, pa3); pv_one<1>(o[1], vb, pa0, pa1, pa2, pa3); pv_one<2>(o[2], vb, pa0, pa1, pa2, pa3); pv_one<3>(o[3], vb, pa0, pa1, pa2, pa3);
}

struct Stage1 { bf16x8 vs0, vs1, ks0, ks1; };
struct Carry { bf16x8 qr[8]; Stage1 st; };
template <bool WIN, int SDEPTH = 2>
__device__ __forceinline__ void attn_body(const bf16* __restrict__ Qb, const bf16* __restrict__ Kh, const bf16* __restrict__ Vh,
                                          bf16* __restrict__ Ob, int ntiles, int dq0, float sink, float sinkB, char* lds,
                                          Carry& cy, bool preloaded, const bf16* __restrict__ nQb, const bf16* __restrict__ nKh, const bf16* __restrict__ nVh, bool has_next) {
  int tid = threadIdx.x; asm volatile("" : "+v"(tid));
  const int wid = __builtin_amdgcn_readfirstlane(tid >> 6), lane = tid & 63, r32 = lane & 31, hi = lane >> 5;
  bf16* V_lds = (bf16*)lds; bf16* K_lds = (bf16*)(lds + 2 * SHM_V);
  float* ws = (float*)(lds + 2 * SHM_V + 2 * SHM_K) + wid * 64; float* li_l = ws; float* al_l = ws + 32;
  const int wrow = WIN ? (wid & 3) * QBLK : wid * QBLK, hsel = WIN ? (wid >> 2) * D : 0;
  float m_reg = WIN ? (hsel ? sinkB : sink) * (1.0f / SCALE) : -1e30f, l_reg = WIN ? 1.f : 0.f; f32x16 o[4] = {}; bf16x8 (&qr)[8] = cy.qr;
  if (!preloaded) { const bf16* Qw = Qb + (long)(wrow + r32) * LDQ + hsel + hi * 8;
#pragma unroll
    for (int d0 = 0; d0 < 8; ++d0) qr[d0] = *reinterpret_cast<const bf16x8*>(Qw + d0 * 16); }
  const int sr = tid >> 4, sc = (tid & 15) * 8, vst0 = v_st(sr, sc), vst1 = v_st(32 + sr, sc);
  const int vb0 = (int)(uintptr_t)V_lds + v_rd_base(lane);
  const int dkl = dq0 - (wrow + r32);
  static_assert(SDEPTH == 1, "cross-unit prefetch uses the single staging slot"); Stage1 (&sr_)[1] = reinterpret_cast<Stage1 (&)[1]>(cy.st);
#define SLOADP(Kp, Vp) do { sr_[0].vs0 = *reinterpret_cast<const bf16x8*>(&(Vp)[(long)sr * LDK + sc]); sr_[0].vs1 = *reinterpret_cast<const bf16x8*>(&(Vp)[(long)(32 + sr) * LDK + sc]); \
    sr_[0].ks0 = *reinterpret_cast<const bf16x8*>(&(Kp)[(long)sr * LDK + sc]); sr_[0].ks1 = *reinterpret_cast<const bf16x8*>(&(Kp)[(long)(32 + sr) * LDK + sc]); } while (0)
#define SLOAD(i, k0) do { sr_[i].vs0 = *reinterpret_cast<const bf16x8*>(&Vh[(long)((k0) + sr) * LDK + sc]); sr_[i].vs1 = *reinterpret_cast<const bf16x8*>(&Vh[(long)((k0) + 32 + sr) * LDK + sc]); \
    sr_[i].ks0 = *reinterpret_cast<const bf16x8*>(&Kh[(long)((k0) + sr) * LDK + sc]); sr_[i].ks1 = *reinterpret_cast<const bf16x8*>(&Kh[(long)((k0) + 32 + sr) * LDK + sc]); } while (0)
#define SWRITE(b, i) do { *(bf16x8*)((char*)V_lds + (b) * SHM_V + vst0) = sr_[i].vs0;          \
    *(bf16x8*)((char*)V_lds + (b) * SHM_V + vst1) = sr_[i].vs1; int kc = sc * 2;               \
    *(bf16x8*)((char*)K_lds + (b) * SHM_K + KSWZ(sr, kc)) = sr_[i].ks0;                       \
    *(bf16x8*)((char*)K_lds + (b) * SHM_K + KSWZ(32 + sr, kc)) = sr_[i].ks1; } while (0)
#define SWAIT() do { if constexpr (SDEPTH == 2) asm volatile("s_waitcnt vmcnt(4)" ::: "memory"); else asm volatile("s_waitcnt vmcnt(0)" ::: "memory"); } while (0)
#define RESC(a) do { if (__any((a) < 1.f)) { if (hi == 0) al_l[r32] = (a); asm volatile("s_waitcnt lgkmcnt(0)" ::: "memory"); \
    for (int d = 0; d < 4; ++d) for (int r = 0; r < 16; ++r) o[d][r] *= al_l[crow(r, hi)]; } } while (0)
#define WMASK(P0, P1, j) do { if (WIN) { const int dw = dq0 + (j) * KVBLK - wrow; if (!(dw + 63 <= 128 && dw - 31 >= -128)) wmask(P0, P1, dkl + (j) * KVBLK, hi); } } while (0)
  f32x16 pA0, pA1, pB0, pB1; float mnA, mnB, alA = 1.f, alB = 1.f; bf16x8 pa0, pa1, pa2, pa3; const int NT = ntiles;
  const float acc0 = WIN ? 0.f : sink;
#define PSM(P0, P1, MN, AL) do { if constexpr (WIN) partialSM(P0, P1, m_reg, MN, AL); else partialSM_nomax(P0); } while (0)
#define RESCW(a) do { if constexpr (WIN) RESC(a); } while (0)
  if (wid >= 4) __builtin_amdgcn_s_setprio(1);
  constexpr int SE = 0, SO = SDEPTH - 1;
  if (!preloaded) SLOADP(Kh, Vh);
  asm volatile("s_waitcnt vmcnt(0)" ::: "memory"); SWRITE(0, SE);
  SLOAD(SO, KVBLK); if constexpr (SDEPTH == 2) { if (2 < NT) SLOAD(SE, 2 * KVBLK); }
  __syncthreads();
  qkt(pA0, pA1, K_lds, qr, r32, hi, acc0); WMASK(pA0, pA1, 0); PSM(pA0, pA1, mnA, alA);
  SWAIT(); SWRITE(1, SO); __syncthreads();
  for (int j = 1; j + 1 < NT; j += 2) {
    SBAR(); qkt(pB0, pB1, (bf16*)((char*)K_lds + SHM_K), qr, r32, hi, acc0); WMASK(pB0, pB1, j);
    finishSM(pA0, pA1, alA, l_reg, pa0, pa1, pa2, pa3); SBAR();
    SLOAD(SO, (j + SDEPTH) * KVBLK); SBAR();
    pv_d0(o, vb0, pa0, pa1, pa2, pa3); PSM(pB0, pB1, mnB, alB);
    __syncthreads(); SWAIT(); SWRITE(0, SE);
    RESCW(alB); __syncthreads();
    SBAR(); qkt(pA0, pA1, K_lds, qr, r32, hi, acc0); WMASK(pA0, pA1, j + 1);
    finishSM(pB0, pB1, alB, l_reg, pa0, pa1, pa2, pa3); SBAR();
    if (SDEPTH == 1 || j + 3 < NT) SLOAD(SE, (j + 1 + SDEPTH) * KVBLK); SBAR();
    pv_d0(o, vb0 + (int)SHM_V, pa0, pa1, pa2, pa3); PSM(pA0, pA1, mnA, alA);
    __syncthreads(); SWAIT(); SWRITE(1, SO);
    RESCW(alA); __syncthreads();
  }
  SBAR(); qkt(pB0, pB1, (bf16*)((char*)K_lds + SHM_K), qr, r32, hi, acc0); WMASK(pB0, pB1, NT - 1);
  SBAR();
  if (has_next) { const bf16* Qn = nQb + (long)(wrow + r32) * LDQ + hsel + hi * 8;
#pragma unroll
    for (int d0 = 0; d0 < 8; ++d0) qr[d0] = *reinterpret_cast<const bf16x8*>(Qn + d0 * 16);
    SLOADP(nKh, nVh); }
  SBAR();
  finishSM(pA0, pA1, alA, l_reg, pa0, pa1, pa2, pa3); SBAR();
  pv_d0(o, vb0, pa0, pa1, pa2, pa3); PSM(pB0, pB1, mnB, alB);
  __syncthreads(); RESCW(alB);
  finishSM(pB0, pB1, alB, l_reg, pa0, pa1, pa2, pa3); SBAR();
  pv_d0(o, vb0 + (int)SHM_V, pa0, pa1, pa2, pa3);
  __builtin_amdgcn_s_setprio(0);
  if (hi == 0) li_l[r32] = l_reg; asm volatile("s_waitcnt lgkmcnt(0)" ::: "memory");
  float rli[16];
#pragma unroll
  for (int r = 0; r < 16; ++r) rli[r] = __builtin_amdgcn_rcpf(li_l[crow(r, hi)]);
  __syncthreads();
  unsigned short* stg = (unsigned short*)(lds + wid * 8192);
#pragma unroll
  for (int r = 0; r < 16; ++r) { const int orow = crow(r, hi);
#pragma unroll
    for (int d0 = 0; d0 < 4; ++d0) { const unsigned w = cvtpk(o[d0][r] * rli[r], 0.f); stg[orow * 128 + d0 * 32 + r32] = (unsigned short)w; } }
  asm volatile("s_waitcnt lgkmcnt(0)" ::: "memory");
  bf16* Ow = Ob + (long)wrow * LDO + hsel;
#pragma unroll
  for (int i = 0; i < 8; ++i) { const int idx = i * 64 + lane, row = idx >> 4, c8 = (idx & 15) * 8;
    const u32x4 v = *reinterpret_cast<const u32x4*>(stg + row * 128 + c8);
    *reinterpret_cast<u32x4*>(Ow + (long)row * LDO + c8) = v; }
  __syncthreads();
#undef SLOAD
#undef SLOADP
#undef SWRITE
#undef SWAIT
#undef RESC
#undef WMASK
#undef PSM
#undef RESCW
}
#undef KSWZ
#undef SBAR
}
#ifndef MK_LAUNCH_MODE
#define MK_LAUNCH_MODE 1
#endif
constexpr int NWAVES = 8;
constexpr int DM = 2048, NTOK = 40960, S0 = 8192, S1 = 4096, NBATCH = 9, DEPTH = 4, INW = 7168, DFF = 5632, NMOD = 6 * DM;
constexpr int Z_QA = 0, Z_KA = 1024, Z_VA = 1280, Z_QB = 1536, Z_KB = 2560, Z_VB = 2816, Z_GA = 3072, Z_GB = 5120;
constexpr float EPS = 1e-6f;
constexpr size_t MiB = 1u << 20;
constexpr size_t WS_CTL = 0, CTL_ZERO_BYTES = 1 * MiB;
constexpr size_t WS_MOD = 1 * MiB;
constexpr size_t WS_TAB = 3 * MiB;
constexpr size_t TAB_COS1 = 0, TAB_SIN1 = 8192 * 64, TAB_CR = 2 * 8192 * 64, TAB_SR = TAB_CR + 128 * 32, TAB_CC = TAB_SR + 128 * 32, TAB_SC = TAB_CC + 64 * 32;
constexpr size_t WS_WT = 8 * MiB;
constexpr size_t W_IN = 0, W_BR = W_IN + (size_t)INW * DM, W_OUT = W_BR + (size_t)DM * DM, W_13 = W_OUT + (size_t)DM * DM, W_2 = W_13 + (size_t)2 * DFF * DM, LAYER_W = W_2 + (size_t)DM * DFF;
constexpr size_t WS_U = WS_WT + DEPTH * LAYER_W * 2;
constexpr size_t WS_Z = WS_U + (size_t)NTOK * DM * 2;
constexpr size_t WS_O = WS_Z + (size_t)NTOK * INW * 2;
constexpr size_t WS_MG = WS_U;
constexpr size_t WS_X = WS_O + (size_t)NTOK * DM * 2;
constexpr size_t WS_END = WS_X + (size_t)NTOK * DM * 2;
static_assert(WS_WT % 256 == 0 && WS_U % 256 == 0 && WS_Z % 256 == 0 && WS_O % 256 == 0 && WS_X % 256 == 0, "ws map alignment");
static_assert((size_t)NTOK * DFF * 2 <= (size_t)NTOK * INW * 2, "H overlays Z");
constexpr int CW_TMO = 0, CW_CODE = 1, CW_BAR = 4096;
constexpr int RING_OFF = 0, RING_BYTES = 131072, LDSCTL_OFF = RING_BYTES, MISC_OFF = LDSCTL_OFF + 320, XCH_OFF = LDSCTL_OFF + 1024  , LDS_BYTES = 147456;
static_assert(XCH_OFF + 8192 <= LDS_BYTES, "LDS map");
constexpr int PH_PRO = 0, PH_NORM0 = 1, PH_L0 = 2, PH_PER_LAYER = 8, N_PHASES = PH_L0 + DEPTH * PH_PER_LAYER;

#define GAS __attribute__((address_space(1)))
#define LAS __attribute__((address_space(3)))
typedef unsigned short bf16;
typedef unsigned v4u __attribute__((ext_vector_type(4)));
typedef unsigned v2u __attribute__((ext_vector_type(2)));
typedef float f32x4 __attribute__((ext_vector_type(4)));
typedef GAS unsigned gu32;
#define RLX_AGENT __ATOMIC_RELAXED, __HIP_MEMORY_SCOPE_AGENT
#define LDS_WAIT() asm volatile("s_waitcnt lgkmcnt(0)" ::: "memory")
#define VM_WAIT() asm volatile("s_waitcnt vmcnt(0)" ::: "memory")
__device__ __forceinline__ unsigned f2bf(float f) { unsigned u = __builtin_bit_cast(unsigned, f); return (u + 0x7fffu + ((u >> 16) & 1u)) >> 16; }
__device__ __forceinline__ unsigned pk2(float lo, float hi) { return f2bf(lo) | (f2bf(hi) << 16); }
__device__ __forceinline__ float bflo(unsigned w) { return __uint_as_float(w << 16); }
__device__ __forceinline__ float bfhi(unsigned w) { return __uint_as_float(w & 0xffff0000u); }

#define XB_TMO      128
#define XB_XCNT(j)  (256  + 64 * (j))
#define XB_XSUB(j)  (1280 + 64 * (j))
#define XB_XGEN(j)  (2304 + 64 * (j))
#define XB_TOP      3328
#define XB_TOPGEN   3392
#define XCD_BAR_WORDS 3456
#define XB_SPIN_CAP (1u << 18)

__device__ __forceinline__ unsigned xb_ld(unsigned* p)              { return __hip_atomic_load(p, __ATOMIC_RELAXED, __HIP_MEMORY_SCOPE_AGENT); }
__device__ __forceinline__ unsigned xb_add(unsigned* p, unsigned v) { return __hip_atomic_fetch_add(p, v, __ATOMIC_RELAXED, __HIP_MEMORY_SCOPE_AGENT); }
__device__ __forceinline__ unsigned xb_xcc_id() { return (unsigned)__builtin_amdgcn_s_getreg((3 << 11) | 20) & 0xFu; }
#define XB_SPIN(cond, bar) do { unsigned _sp = 0; while (cond) { __builtin_amdgcn_s_sleep(1); \
    if ((++_sp & 255u) == 0u) { if (xb_ld(&(bar)[XB_TMO])) break; if (_sp > XB_SPIN_CAP) { atomicAdd(&(bar)[XB_TMO], 1u); break; } } } } while (0)

struct XcdBarrier {
    unsigned* bar; unsigned x;
    volatile LAS unsigned* st;
};

__device__ __forceinline__ XcdBarrier xcd_barrier_post(unsigned* bar, volatile LAS unsigned* st) {
    XcdBarrier b; b.bar = bar; b.x = xb_xcc_id(); b.st = st;
    if (threadIdx.x == 0) (void)xb_add(&bar[XB_XCNT(b.x)], 1u);
    return b;
}
__device__ __forceinline__ void xcd_barrier_complete(unsigned* bar, unsigned x, unsigned& nloc, unsigned& nx) {
    const unsigned G = gridDim.x * gridDim.y * gridDim.z;
    unsigned sum, cnt, mine, sp = 0u;
    for (;;) {
        sum = 0u; cnt = 0u; mine = 0u;
#pragma unroll
        for (unsigned j = 0; j < 16; ++j) { const unsigned c = xb_ld(&bar[XB_XCNT(j)]); sum += c; cnt += (c > 0u) ? 1u : 0u; mine = (j == x) ? c : mine; }
        if (sum == G) break;
        __builtin_amdgcn_s_sleep(1);
        if ((++sp & 255u) == 0u) { if (xb_ld(&bar[XB_TMO])) break; if (sp > XB_SPIN_CAP) { atomicAdd(&bar[XB_TMO], 1u); break; } }
    }
    nloc = mine > 0u ? mine : 1u; nx = cnt > 0u ? cnt : 1u;
}

__device__ __forceinline__ void xcd_barrier(const XcdBarrier& b) {
    asm volatile("s_waitcnt vmcnt(0)" ::: "memory");
    __syncthreads();
    if (threadIdx.x == 0) {
        unsigned* bar = b.bar;
        __builtin_amdgcn_s_waitcnt(0);
        unsigned nloc = b.st[0], nx = b.st[1];
        if (nloc == 0u) { xcd_barrier_complete(bar, b.x, nloc, nx); b.st[0] = nloc; b.st[1] = nx; }
        const unsigned old = xb_add(&bar[XB_XSUB(b.x)], 1u);
        const unsigned gen = old / nloc;
        if (old + 1u == (gen + 1u) * nloc) {
            __builtin_amdgcn_fence(__ATOMIC_RELEASE, "agent");
            asm volatile("s_waitcnt vmcnt(0)" ::: "memory");
            const unsigned og = xb_add(&bar[XB_TOP], 1u);
            const unsigned tg = og / nx;
            if (og + 1u == (tg + 1u) * nx) xb_add(&bar[XB_TOPGEN], 1u);
            else XB_SPIN(xb_ld(&bar[XB_TOPGEN]) == tg, bar);
            __builtin_amdgcn_fence(__ATOMIC_ACQUIRE, "agent");
            xb_add(&bar[XB_XGEN(b.x)], 1u);
            asm volatile("s_waitcnt vmcnt(0)" ::: "memory");
        } else {
            XB_SPIN(xb_ld(&bar[XB_XGEN(b.x)]) == gen, bar);
            __builtin_amdgcn_fence(__ATOMIC_ACQUIRE, "agent");
            asm volatile("s_waitcnt vmcnt(0)" ::: "memory");
        }
    }
    __syncthreads();
}


struct Args { const float* in[19]; float* out; unsigned char* ws; int ph_lo, ph_hi, li, pad; };

__device__ __forceinline__ float wave_sum(float v) {
#pragma unroll
    for (int o = 1; o < 64; o <<= 1) v += __shfl_xor(v, o);
    return v;
}
__device__ __forceinline__ int row_batch(int row) { return row < S0 ? 0 : 1 + ((row - S0) >> 12); }
__device__ __forceinline__ int row_pos(int row) { return row < S0 ? row : ((row - S0) & (S1 - 1)); }

__device__ __forceinline__ void sincos_d(double a, float& s, float& c) {
    const double q = __builtin_rint(a * 0.63661977236758134308);
    double r = __builtin_fma(-q, 1.5707963267948966, a); r = __builtin_fma(-q, 6.123233995736766e-17, r);
    const double r2 = r * r;
    double sp = 1.0 / 6227020800.0; sp = sp * r2 - 1.0 / 39916800.0; sp = sp * r2 + 1.0 / 362880.0; sp = sp * r2 - 1.0 / 5040.0; sp = sp * r2 + 1.0 / 120.0; sp = sp * r2 - 1.0 / 6.0; sp = sp * r2 + 1.0; sp = sp * r;
    double cp = -1.0 / 87178291200.0; cp = cp * r2 + 1.0 / 479001600.0; cp = cp * r2 - 1.0 / 3628800.0; cp = cp * r2 + 1.0 / 40320.0; cp = cp * r2 - 1.0 / 720.0; cp = cp * r2 + 1.0 / 24.0; cp = cp * r2 - 0.5; cp = cp * r2 + 1.0;
    const int qi = (int)((long long)q & 3);
    const double ss = (qi & 1) ? cp : sp, cc = (qi & 1) ? sp : cp;
    s = (float)((qi & 2) ? -ss : ss); c = (float)(((qi + 1) & 2) ? -cc : cc);
}
__device__ __forceinline__ float inv_freq(int i, double base) { double v = 1.0; for (int k = 0; k < i; ++k) v *= base; return (float)v; }
__device__ __forceinline__ void p0_tables(float* tab, int gt, int ngt) {
    for (int idx = gt; idx < 8192 * 64; idx += ngt) { const int pos = idx >> 6, i = idx & 63; const float f = inv_freq(i, 0.8659643233600653); const float ang = (float)pos * f;
        float s, c; sincos_d((double)ang, s, c); const int ix = (((pos >> 4) * 16 + (i >> 2)) * 16 + (pos & 15)) * 4 + (i & 3);
        tab[TAB_COS1 + ix] = c; tab[TAB_SIN1 + ix] = s; }
    for (int idx = gt; idx < 128 * 32; idx += ngt) { const int pos = idx >> 5, i = idx & 31; const float f = inv_freq(i, 0.7498942093324558); const float ang = (float)pos * f;
        float s, c; sincos_d((double)ang, s, c); tab[TAB_CR + idx] = c; tab[TAB_SR + idx] = s; if (pos < 64) { const int ix = (((pos >> 4) * 8 + (i >> 2)) * 16 + (pos & 15)) * 4 + (i & 3);
            tab[TAB_CC + ix] = c; tab[TAB_SC + ix] = s; } }
}
__device__ __forceinline__ void p0_mod_item(const float* cp, const float* cs, const float* wmod, const float* bmod, float* mod, LAS float* sc, int item, int tid, int wave, int lane) {
    const int l = item / (NMOD / 256), col0 = (item % (NMOD / 256)) * 256;
    for (int i = tid; i < NBATCH * DM; i += 512) { const float v = (i < DM) ? cp[i] : cs[i - DM]; sc[i] = v * __builtin_amdgcn_rcpf(1.0f + __expf(-v)); }
    __syncthreads();
    f32x4 acc[NBATCH];
#pragma unroll
    for (int b = 0; b < NBATCH; ++b) acc[b] = (f32x4){0.f, 0.f, 0.f, 0.f};
    const float* wp = wmod + (size_t)l * DM * NMOD + (size_t)(wave * 256) * NMOD + col0 + lane * 4;
    for (int k16 = 0; k16 < 16; ++k16) {
        f32x4 w[16];
#pragma unroll
        for (int kk = 0; kk < 16; ++kk) w[kk] = *(const f32x4*)(wp + (size_t)(k16 * 16 + kk) * NMOD);
#pragma unroll
        for (int q = 0; q < 4; ++q)
#pragma unroll
            for (int b = 0; b < NBATCH; ++b) { const f32x4 s4 = *(const LAS f32x4*)(sc + b * DM + wave * 256 + k16 * 16 + q * 4);
                acc[b] += w[4 * q + 0] * s4[0]; acc[b] += w[4 * q + 1] * s4[1]; acc[b] += w[4 * q + 2] * s4[2]; acc[b] += w[4 * q + 3] * s4[3]; }
    }
    __syncthreads();
#pragma unroll
    for (int b = 0; b < NBATCH; ++b) *(LAS f32x4*)(sc + (wave * NBATCH + b) * 256 + lane * 4) = acc[b];
    __syncthreads();
    for (int i = tid; i < NBATCH * 256; i += 512) { const int b = i >> 8, c = i & 255; float s = bmod[(size_t)l * NMOD + col0 + c];
#pragma unroll
        for (int w = 0; w < NWAVES; ++w) s += sc[(w * NBATCH + b) * 256 + c];
        mod[((size_t)l * NBATCH + b) * NMOD + col0 + c] = s; }
    __syncthreads();
}
__device__ __forceinline__ int zperm(int n) {
    if (n >= Z_GA) { const int c = (n - Z_GA) & 2047; return Z_GA + 256 * (c >> 7) + ((n - Z_GA) >> 11) * 128 + (c & 127); }
    const int mode = (n < 1280) ? 1 : (n < 1536) ? 0 : (n < 2816) ? 2 : 0;
    if (mode == 0) return n;
    const int base = n & ~127, e = n & 127;
    if (mode == 1) { const int m = e & 63; return base + 8 * (m >> 2) + 4 * (e >> 6) + (m & 3); }
    const int q = e >> 5, m = e & 31; return base + 8 * ((q >> 1) * 8 + (m >> 2)) + 4 * (q & 1) + (m & 3);
}
constexpr int I_IN = (DM / 64) * (INW / 32), I_BR = (1024 / 64) * (DM / 32), I_OUT = (DM / 64) * (DM / 32), I_13 = (DM / 64) * (2 * DFF / 32), I_2 = (DFF / 64) * (DM / 32);
constexpr int I_LAYER = I_IN + 2 * I_BR + I_OUT + I_13 + I_2;
struct TrItem { const float* src; bf16* dst; int N, ldk, drow0; bool zp; float scl; };
template <class AP> __device__ __forceinline__ TrItem tr_decode(AP a, bf16* wt, int it) {
    const int l = it / I_LAYER; int r = it % I_LAYER; bf16* wl = wt + (size_t)l * LAYER_W; TrItem t;
    if (r < I_IN) { const int nb = r % (INW / 32), kb = r / (INW / 32); t.src = a->in[10] + (size_t)l * DM * INW + (size_t)(64 * kb) * INW + 32 * nb; t.N = INW; t.dst = wl + W_IN + 64 * kb; t.ldk = DM; t.drow0 = 32 * nb; t.zp = true; t.scl = (32 * nb >= Z_GA) ? -1.4426950408889634f : 1.0f; return t; } r -= I_IN;
    if (r < I_BR) { const int nb = r % (DM / 32), kb = r / (DM / 32); t.src = a->in[14] + (size_t)l * 1024 * DM + (size_t)(64 * kb) * DM + 32 * nb; t.N = DM; t.dst = wl + W_BR + 64 * kb; t.ldk = DM; t.drow0 = 32 * nb; t.zp = false; t.scl = 1.0f; return t; } r -= I_BR;
    if (r < I_BR) { const int nb = r % (DM / 32), kb = r / (DM / 32); t.src = a->in[15] + (size_t)l * 1024 * DM + (size_t)(64 * kb) * DM + 32 * nb; t.N = DM; t.dst = wl + W_BR + 1024 + 64 * kb; t.ldk = DM; t.drow0 = 32 * nb; t.zp = false; t.scl = 1.0f; return t; } r -= I_BR;
    if (r < I_OUT) { const int nb = r % (DM / 32), kb = r / (DM / 32); t.src = a->in[16] + (size_t)l * DM * DM + (size_t)(64 * kb) * DM + 32 * nb; t.N = DM; t.dst = wl + W_OUT + 64 * kb; t.ldk = DM; t.drow0 = 32 * nb; t.zp = false; t.scl = 1.0f; return t; } r -= I_OUT;
    if (r < I_13) { const int nb = r % (2 * DFF / 32), kb = r / (2 * DFF / 32); const int n0 = 32 * nb; const int j = n0 < DFF ? n0 : n0 - DFF; const int drow = 256 * (j >> 7) + (n0 < DFF ? 0 : 128) + (j & 127);
        t.src = a->in[17] + (size_t)l * DM * 2 * DFF + (size_t)(64 * kb) * (2 * DFF) + n0; t.N = 2 * DFF; t.dst = wl + W_13 + 64 * kb; t.ldk = DM; t.drow0 = drow; t.zp = false; t.scl = (n0 < DFF) ? -1.4426950408889634f : -0.6931471805599453f; return t; } r -= I_13;
    { const int nb = r % (DM / 32), kb = r / (DM / 32); t.src = a->in[18] + (size_t)l * DFF * DM + (size_t)(64 * kb) * DM + 32 * nb; t.N = DM; t.dst = wl + W_2 + 64 * kb; t.ldk = DFF; t.drow0 = 32 * nb; t.zp = false; t.scl = 1.0f; return t; }
}
__device__ __forceinline__ void tr_load(const TrItem& t, float (&wv)[32], int lane) {
#pragma unroll
    for (int i = 0; i < 32; ++i) { const int kk = 2 * i + (lane >> 5); wv[i] = t.src[(size_t)kk * t.N + (lane & 31)]; }
}
__device__ __forceinline__ void tr_store(const TrItem& t, const float (&wv)[32], LAS float* scr, int lane) {
#pragma unroll
    for (int i = 0; i < 32; ++i) { const int kk = 2 * i + (lane >> 5); scr[kk * 33 + (lane & 31)] = wv[i]; }
    LDS_WAIT(); asm volatile("" ::: "memory");
    const int c = lane & 7;
#pragma unroll
    for (int j = 0; j < 4; ++j) { const int n = (lane >> 3) + 8 * j; const LAS float* s = scr + (8 * c) * 33 + n;
        const float q = t.scl;
        v4u o; o.x = pk2(s[0 * 33] * q, s[1 * 33] * q); o.y = pk2(s[2 * 33] * q, s[3 * 33] * q); o.z = pk2(s[4 * 33] * q, s[5 * 33] * q); o.w = pk2(s[6 * 33] * q, s[7 * 33] * q);
        const int dr = t.zp ? zperm(t.drow0 + n) : t.drow0 + n;
        *(GAS v4u*)(t.dst + (size_t)dr * t.ldk + 8 * c) = o; }
    LDS_WAIT(); asm volatile("" ::: "memory");
}
template <class AP> __device__ __forceinline__ void p0_transposes(AP a, bf16* wt, LAS float* scr, int it0, int it1, int gw, int ngw, int lane) {
    int it = it0 + gw; if (it >= it1) return;
    float wa[32], wb[32]; TrItem cur = tr_decode(a, wt, it); tr_load(cur, wa, lane);
    for (;;) {
        int nit = it + ngw; TrItem nxt = cur; const bool hn = nit < it1; if (hn) { nxt = tr_decode(a, wt, nit); tr_load(nxt, wb, lane); }
        tr_store(cur, wa, scr, lane); if (!hn) break;
        it = nit + ngw; const bool h2 = it < it1; if (h2) { cur = tr_decode(a, wt, it); tr_load(cur, wa, lane); }
        tr_store(nxt, wb, scr, lane); if (!h2) break;
    }
}

template <int MODE, bool DO_U>
__device__ __forceinline__ void norm_phase(const float* xin, const float* xin2, bf16* xb, float* xout, const bf16* y, bf16* u, const float* g_post, const float* gate, const float* g_pre, const float* scale, const float* shift,
                                           int gw, int ngw, int lane) {
    const int rpw = (NTOK + ngw - 1) / ngw, r0 = gw * rpw, r1 = (r0 + rpw < NTOK) ? r0 + rpw : NTOK;
    f32x4 A[8], Bv[8], Cv[8]; int curb = -1;
    const int cl = 4 * lane, yp = 64 * ((cl >> 5) & 3) + 32 * (cl >> 7) + (cl & 31);
    v2u xw[8], yw[8];
#define NORM_FETCH(row_) do { const bf16* xr_ = xb + (size_t)(row_) * DM + 4 * lane; const bf16* yr_ = y + (size_t)(row_) * DM + yp; \
        _Pragma("unroll") for (int j = 0; j < 8; ++j) xw[j] = *(const v2u*)(xr_ + 256 * j); _Pragma("unroll") for (int j = 0; j < 8; ++j) yw[j] = *(const v2u*)(yr_ + 256 * j); } while (0)
    if (MODE == 1 && r0 < r1) NORM_FETCH(r0);
    f32x4 xf[8];
    if (MODE == 0 && r0 < r1) { const float* xr = (r0 < S0 ? xin + (size_t)r0 * DM : xin2 + (size_t)(r0 - S0) * DM) + 4 * lane;
#pragma unroll
        for (int j = 0; j < 8; ++j) xf[j] = *(const f32x4*)(xr + 256 * j); }
    for (int row = r0; row < r1; ++row) {
        const int b = row_batch(row);
        if (b != curb) { curb = b; int l4 = 4 * lane; asm volatile("" : "+v"(l4));
#pragma unroll
            for (int j = 0; j < 8; ++j) { const int c = 256 * j + l4;
                if (MODE == 1) A[j] = *(const f32x4*)(gate + (size_t)b * NMOD + c) * *(const f32x4*)(g_post + c);
                if (DO_U) { Bv[j] = *(const f32x4*)(g_pre + c) * (*(const f32x4*)(scale + (size_t)b * NMOD + c) + 1.0f); Cv[j] = *(const f32x4*)(shift + (size_t)b * NMOD + c); } } }
        f32x4 x[8];
        if (MODE == 0) {
#pragma unroll
            for (int j = 0; j < 8; ++j) x[j] = xf[j];
            if (row + 1 < r1) { const int rn = row + 1; const float* xr = (rn < S0 ? xin + (size_t)rn * DM : xin2 + (size_t)(rn - S0) * DM) + 4 * lane;
#pragma unroll
                for (int j = 0; j < 8; ++j) xf[j] = *(const f32x4*)(xr + 256 * j); } }
        else {
            float ss = 0.f;
#pragma unroll
            for (int j = 0; j < 8; ++j) { const v2u w = xw[j]; x[j] = (f32x4){bflo(w.x), bfhi(w.x), bflo(w.y), bfhi(w.y)}; }
#pragma unroll
            for (int j = 0; j < 8; ++j) { const v2u w = yw[j]; const f32x4 yv = (f32x4){bflo(w.x), bfhi(w.x), bflo(w.y), bfhi(w.y)}; ss += (yv[0] * yv[0] + yv[1] * yv[1]) + (yv[2] * yv[2] + yv[3] * yv[3]); }
            const float rstd = __builtin_amdgcn_rsqf(wave_sum(ss) * (1.0f / DM) + EPS);
#pragma unroll
            for (int j = 0; j < 8; ++j) { const v2u w = yw[j]; const f32x4 yv = (f32x4){bflo(w.x), bfhi(w.x), bflo(w.y), bfhi(w.y)}; x[j] += A[j] * (yv * rstd); }
            if (row + 1 < r1) NORM_FETCH(row + 1);
        }
        if (DO_U) {
            bf16* xo = xb + (size_t)row * DM + 4 * lane; float ss = 0.f;
#pragma unroll
            for (int j = 0; j < 8; ++j) { v2u w; w.x = pk2(x[j][0], x[j][1]); w.y = pk2(x[j][2], x[j][3]); *(v2u*)(xo + 256 * j) = w; ss += (x[j][0] * x[j][0] + x[j][1] * x[j][1]) + (x[j][2] * x[j][2] + x[j][3] * x[j][3]); }
            const float rstd = __builtin_amdgcn_rsqf(wave_sum(ss) * (1.0f / DM) + EPS);
            bf16* ur = u + (size_t)row * DM + 4 * lane;
#pragma unroll
            for (int j = 0; j < 8; ++j) { const f32x4 v = x[j] * rstd * Bv[j] + Cv[j]; v2u w; w.x = pk2(v[0], v[1]); w.y = pk2(v[2], v[3]); *(v2u*)(ur + 256 * j) = w; }
        } else {
            float* xo = xout + (size_t)row * DM + 4 * lane;
#pragma unroll
            for (int j = 0; j < 8; ++j) *(f32x4*)(xo + 256 * j) = x[j];
        }
    }
#undef NORM_FETCH
}

__device__ __forceinline__ void attn_phase(const bf16* z, bf16* oab, const float* sink, const float* qn, const float* kn, char* lds, int c, int G) {
    const int x = c & 7, jj = c >> 3, per = (G - x + 7) >> 3;
    float nacc0;
    { const int ln = threadIdx.x & 63; float gq = fmaxf(fabsf(qn[ln]), fabsf(qn[ln + 64])), gk = fmaxf(fabsf(kn[ln]), fabsf(kn[ln + 64]));
#pragma unroll
      for (int o = 1; o < 64; o <<= 1) { gq = fmaxf(gq, __shfl_xor(gq, o)); gk = fmaxf(gk, __shfl_xor(gk, o)); }
      const float bnd = 1.01f * 128.0f * 0.12751743082459868f * gq * gk; nacc0 = -fmaxf(bnd - 40.0f, 0.0f); }
#ifndef MK_REPEAT_ATT
#define MK_REPEAT_ATT 0
#endif
    att::Carry cy;
    for (int rep = 0; rep < ((MK_REPEAT_ATT & 1) ? 2 : 1); ++rep) { bool pre = false;
    for (int T = jj; T < 160; T += per) { const bool pr = T < 32; const int w = T - 32, h = pr ? x : (w >> 4), qb = pr ? T : (w & 15); const size_t r0 = pr ? 0 : S0 + (size_t)x * S1;
        const int Tn = T + per; const bool hn = Tn < 160; const bool prn = Tn < 32; const int wn = Tn - 32, hnx = prn ? x : (wn >> 4), qbn = prn ? Tn : (wn & 15); const size_t r0n = prn ? 0 : S0 + (size_t)x * S1;
        att::attn_body<false, 1>(z + (r0 + 256 * qb) * INW + Z_QB + h * 128, z + r0 * INW + Z_KB + (h >> 2) * 128, z + r0 * INW + Z_VB + (h >> 2) * 128,
                                 oab + (r0 + 256 * qb) * DM + 1024 + h * 128, pr ? S0 / 64 : S1 / 64, 0, nacc0, 0.f, lds,
                                 cy, pre, z + (r0n + 256 * qbn) * INW + Z_QB + hnx * 128, z + r0n * INW + Z_KB + (hnx >> 2) * 128, z + r0n * INW + Z_VB + (hnx >> 2) * 128, hn);
        pre = hn; } }
    { bool pre = false;
    for (int LL = jj; LL < 160; LL += per) {
#define WIN_UNIT(L_, row0_, h_, s0_, klo_, khi_) const int pm##L_ = ((L_) >> 3) * 8 + x, row0_ = 256 * pm##L_ + 128 * (((L_) >> 2) & 1), h_ = 2 * ((L_) & 3); \
        const int s0_ = row0_ < S0 ? 0 : S0 + ((row0_ - S0) & ~(S1 - 1)), S##L_ = row0_ < S0 ? S0 : S1, i0##L_ = row0_ - s0_; \
        const int klo_ = i0##L_ - 128 < 0 ? 0 : i0##L_ - 128, khi_ = i0##L_ + 256 > S##L_ ? S##L_ : i0##L_ + 256
        WIN_UNIT(LL, row0, h, s0, klo, khi); const int Ln = LL + per; const bool hn = Ln < 160; WIN_UNIT(Ln, row0n, hnx, s0n, klon, khin); (void)khin;
        att::attn_body<true, 1>(z + (size_t)row0 * INW + Z_QA + h * 128, z + (size_t)(s0 + klo) * INW + Z_KA + (h >> 2) * 128, z + (size_t)(s0 + klo) * INW + Z_VA + (h >> 2) * 128,
                                oab + (size_t)row0 * DM + h * 128, (khi - klo) / 64, klo - (row0 - s0), sink[h], sink[h + 1], lds,
                                cy, pre, z + (size_t)row0n * INW + Z_QA + hnx * 128, z + (size_t)(s0n + klon) * INW + Z_KA + (hnx >> 2) * 128, z + (size_t)(s0n + klon) * INW + Z_VA + (hnx >> 2) * 128, hn);
        pre = hn; }
#undef WIN_UNIT
    }
}

__device__ __forceinline__ void phase_skew(int bx, unsigned ticks) {
    const unsigned long long want = (unsigned long long)(((unsigned)bx >> 3) & 7u) * ticks, t0 = __builtin_amdgcn_s_memrealtime();
    while (__builtin_amdgcn_s_memrealtime() - t0 < want) __builtin_amdgcn_s_sleep(2);
}
#ifndef MK_SKEW
#define MK_SKEW 0
#endif
typedef const __attribute__((address_space(4))) Args* KArgs;
__device__ __forceinline__ KArgs kargs() { KArgs p = (KArgs)__builtin_amdgcn_kernarg_segment_ptr(); asm volatile("" : "+s"(p)); return p; }
#ifndef MK_KIND_MASK
#define MK_KIND_MASK 0x7ff
#endif
#define KIND(n) ((MK_KIND_MASK >> (n)) & 1)
#ifndef MK_REPEAT_MASK
#define MK_REPEAT_MASK 0
#endif
#define NREP(n) (((MK_REPEAT_MASK >> (n)) & 1) ? 2 : 1)
__global__ void __launch_bounds__(NWAVES * 64, 2) mk_fwd(Args args_unused) {
    extern __shared__ __attribute__((aligned(16))) unsigned char lds[];
    LAS unsigned char* L = (LAS unsigned char*)lds;
    volatile LAS unsigned* MISC = (volatile LAS unsigned*)(L + MISC_OFF);
    const int G = gridDim.x, bx = blockIdx.x, ngw = G * NWAVES;
#define PHASE_IDS int tid = threadIdx.x; asm volatile("" : "+v"(tid)); const int lane = tid & 63, wave = __builtin_amdgcn_readfirstlane(tid >> 6), gw = bx * NWAVES + wave; (void)lane; (void)gw
    for (int u = threadIdx.x; u < (LDS_BYTES - LDSCTL_OFF) / 4; u += NWAVES * 64) ((LAS unsigned*)(L + LDSCTL_OFF))[u] = 0u;
    __syncthreads();
    int lo, hi; XcdBarrier bar;
    { KArgs ap = kargs(); lo = ap->ph_lo; hi = ap->ph_hi; unsigned* bw = (unsigned*)(ap->ws + WS_CTL) + CW_BAR + ap->li * XCD_BAR_WORDS;
      bar.bar = bw; bar.x = 0; bar.st = nullptr; if (hi - lo > 1) bar = xcd_barrier_post(bw, MISC + 8); }
#define IN(k) (lo <= (k) && (k) < hi)
#define SEAM(k) do { if ((k) + 1 < hi) xcd_barrier(bar); } while (0)
#define WSP(T, off) ((T*)(ap->ws + (off)))

    if (KIND(0) && IN(PH_PRO)) {
        KArgs ap = kargs(); PHASE_IDS;
            for (int rep = 0; rep < NREP(0); ++rep) {
        p0_tables(WSP(float, WS_TAB), bx * 512 + tid, G * 512);
        for (int it = bx; it < DEPTH * (NMOD / 256); it += G) p0_mod_item(ap->in[2], ap->in[3], ap->in[8], ap->in[9], WSP(float, WS_MOD), (LAS float*)(L + RING_OFF), it, tid, wave, lane);
        p0_transposes(ap, WSP(bf16, WS_WT), (LAS float*)(L + RING_OFF + wave * 16384), 0, DEPTH * I_LAYER, gw, ngw, lane);
            }
        SEAM(PH_PRO);
    }
    if (KIND(1) && IN(PH_NORM0)) {
        KArgs ap = kargs(); PHASE_IDS; const float* mod = WSP(float, WS_MOD);
        norm_phase<0, true>(ap->in[0], ap->in[1], WSP(bf16, WS_X), nullptr, nullptr, WSP(bf16, WS_U), nullptr, nullptr, ap->in[4], mod + 1 * DM, mod + 0 * DM, gw, ngw, lane);
        SEAM(PH_NORM0);
    }
    for (int l = 0; l < DEPTH; ++l) {
        const int pb = PH_L0 + PH_PER_LAYER * l;
        if (KIND(2) && IN(pb + 0)) {
            KArgs ap = kargs(); PHASE_IDS;
            for (int rep = 0; rep < NREP(2); ++rep) {
            pg8::Gemm g{WSP(bf16, WS_U), WSP(bf16, WS_WT) + (size_t)l * LAYER_W + W_IN, NTOK, INW, DM}; pg8::StaticOrder S; S.init(NTOK, INW, G, bx); S.split_tail();
            pg8::EpiZ E{WSP(bf16, WS_Z), INW, WSP(float, WS_TAB), ap->in[11] + l * 128, ap->in[12] + l * 128, (LAS float*)(L + XCH_OFF)};
            static_assert(pg8::EpiZ::tab_cos1 == TAB_COS1 && pg8::EpiZ::tab_sin1 == TAB_SIN1 && pg8::EpiZ::tab_cr == TAB_CR && pg8::EpiZ::tab_sr == TAB_SR && pg8::EpiZ::tab_cc == TAB_CC && pg8::EpiZ::tab_sc == TAB_SC, "table offsets");
            pg8::gemm_phase<pg8::EpiZ, pg8::StaticOrder, true, true>(L + RING_OFF, g, S, E);
            { pg8::TailOrder T{S}; pg8::gemm_phase<pg8::EpiZ, pg8::TailOrder, true, true, false, true>(L + RING_OFF, g, T, E); }
            }
            SEAM(pb + 0);
        }
        if (KIND(4) && IN(pb + 1)) {
            KArgs ap = kargs(); PHASE_IDS;
            for (int rep = 0; rep < NREP(4); ++rep) {
            attn_phase(WSP(bf16, WS_Z), WSP(bf16, WS_O), ap->in[13] + l * 8, ap->in[11] + l * 128, ap->in[12] + l * 128, (char*)lds + RING_OFF, bx, G);
            }
            SEAM(pb + 1);
        }
        if (KIND(5) && IN(pb + 2)) {
            KArgs ap = kargs(); PHASE_IDS;
            for (int rep = 0; rep < NREP(5); ++rep) {
            pg8::Gemm g{WSP(bf16, WS_O), WSP(bf16, WS_WT) + (size_t)l * LAYER_W + W_BR, NTOK, DM, DM}; pg8::StaticOrder S; S.init(NTOK, DM, G, bx);
            pg8::EpiMerge E{WSP(bf16, WS_MG), DM, 1024 / pg8::BK, WSP(bf16, WS_Z), INW, Z_GA, Z_GB};
            pg8::gemm_phase<pg8::EpiMerge, pg8::StaticOrder, true, true>(L + RING_OFF, g, S, E);
            }
            SEAM(pb + 2);
        }
        if (KIND(6) && IN(pb + 3)) {
            KArgs ap = kargs(); PHASE_IDS;
            for (int rep = 0; rep < NREP(6); ++rep) {
            pg8::Gemm g{WSP(bf16, WS_MG), WSP(bf16, WS_WT) + (size_t)l * LAYER_W + W_OUT, NTOK, DM, DM}; pg8::StaticOrder S; S.init(NTOK, DM, G, bx);
            pg8::EpiPlain E{WSP(bf16, WS_O), DM};
            pg8::gemm_phase<pg8::EpiPlain, pg8::StaticOrder, true, true>(L + RING_OFF, g, S, E);
            }
            SEAM(pb + 3);
        }
        if (KIND(7) && IN(pb + 4)) {
            KArgs ap = kargs(); PHASE_IDS; const float* modl = WSP(float, WS_MOD) + (size_t)l * NBATCH * NMOD;
            norm_phase<1, true>(nullptr, nullptr, WSP(bf16, WS_X), nullptr, WSP(bf16, WS_O), WSP(bf16, WS_U), ap->in[5] + l * DM, modl + 2 * DM, ap->in[6] + l * DM, modl + 4 * DM, modl + 3 * DM, gw, ngw, lane);
            SEAM(pb + 4);
        }
        if (KIND(8) && IN(pb + 5)) {
            KArgs ap = kargs(); PHASE_IDS;
            for (int rep = 0; rep < NREP(8); ++rep) {
            pg8::Gemm g{WSP(bf16, WS_U), WSP(bf16, WS_WT) + (size_t)l * LAYER_W + W_13, NTOK, 2 * DFF, DM}; pg8::StaticOrder S; S.init(NTOK, 2 * DFF, G, bx); S.split_tail();
            pg8::EpiSwiglu E{WSP(bf16, WS_Z), DFF};
            pg8::gemm_phase<pg8::EpiSwiglu, pg8::StaticOrder, true, true>(L + RING_OFF, g, S, E);
            { pg8::TailOrder T{S}; pg8::gemm_phase<pg8::EpiSwiglu, pg8::TailOrder, true, true, false, true>(L + RING_OFF, g, T, E); }
            }
            SEAM(pb + 5);
        }
        if (KIND(9) && IN(pb + 6)) {
            KArgs ap = kargs(); PHASE_IDS;
            for (int rep = 0; rep < NREP(9); ++rep) {
            pg8::Gemm g{WSP(bf16, WS_Z), WSP(bf16, WS_WT) + (size_t)l * LAYER_W + W_2, NTOK, DM, DFF}; pg8::StaticOrder S; S.init(NTOK, DM, G, bx);
            pg8::EpiPlain E{WSP(bf16, WS_O), DM};
            pg8::gemm_phase<pg8::EpiPlain, pg8::StaticOrder, true, true, true>(L + RING_OFF, g, S, E);
            }
            SEAM(pb + 6);
        }
        if (KIND(10) && IN(pb + 7)) {
            KArgs ap = kargs(); PHASE_IDS; const float* modl = WSP(float, WS_MOD) + (size_t)l * NBATCH * NMOD;
            if (l + 1 < DEPTH) { const float* modn = modl + (size_t)NBATCH * NMOD;
                norm_phase<1, true>(nullptr, nullptr, WSP(bf16, WS_X), nullptr, WSP(bf16, WS_O), WSP(bf16, WS_U), ap->in[7] + l * DM, modl + 5 * DM, ap->in[4] + (l + 1) * DM, modn + 1 * DM, modn + 0 * DM, gw, ngw, lane); }
            else norm_phase<1, false>(nullptr, nullptr, WSP(bf16, WS_X), ap->out, WSP(bf16, WS_O), nullptr, ap->in[7] + l * DM, modl + 5 * DM, nullptr, nullptr, nullptr, gw, ngw, lane);
            SEAM(pb + 7);
        }
    }
#undef IN
#undef SEAM
#undef WSP
#undef PHASE_IDS
}

extern "C" void kernel_launch(void* const* d_in, const int* in_sizes, int n_in, void* d_out, int out_size, void* d_ws, size_t ws_size, hipStream_t stream) {
    static int grid = 0;
    if (grid == 0) {
        if (n_in != 19 || out_size != NTOK * DM || ws_size < WS_END) { fprintf(stderr, "kernel_launch: unexpected shapes (n_in %d out %d ws %zu, need ws >= %zu); nothing launched\n", n_in, out_size, ws_size, (size_t)WS_END); grid = -1; return; }
        int dev = 0, cus = 0, per_cu = 0;
        if (hipGetDevice(&dev) != hipSuccess || hipDeviceGetAttribute(&cus, hipDeviceAttributeMultiprocessorCount, dev) != hipSuccess) { grid = -1; return; }
        if (hipFuncSetAttribute((const void*)mk_fwd, hipFuncAttributeMaxDynamicSharedMemorySize, LDS_BYTES) != hipSuccess) { fprintf(stderr, "kernel_launch: hipFuncSetAttribute failed\n"); grid = -1; return; }
        if (hipOccupancyMaxActiveBlocksPerMultiprocessor(&per_cu, (const void*)mk_fwd, NWAVES * 64, LDS_BYTES) != hipSuccess || per_cu < 1) { fprintf(stderr, "kernel_launch: occupancy query says %d blocks per CU\n", per_cu); }
        (void)hipGetLastError();
        grid = cus;
    }
    if (grid < 0) return;
    if (hipMemsetAsync((char*)d_ws + WS_CTL, 0, CTL_ZERO_BYTES, stream) != hipSuccess) return;
    Args a{};
    for (int i = 0; i < 19; ++i) a.in[i] = (const float*)d_in[i];
    a.out = (float*)d_out; a.ws = (unsigned char*)d_ws;
#if MK_LAUNCH_MODE == 1
    a.ph_lo = 0; a.ph_hi = N_PHASES; a.li = 0; a.pad = 0;
    hipLaunchKernelGGL(mk_fwd, dim3(grid), dim3(NWAVES * 64), LDS_BYTES, stream, a);
#else
    for (int p = 0; p < N_PHASES; ++p) { a.ph_lo = p; a.ph_hi = p + 1; a.li = 0; a.pad = 0;
        hipLaunchKernelGGL(mk_fwd, dim3(grid), dim3(NWAVES * 64), LDS_BYTES, stream, a); }
#endif
    const hipError_t le = hipPeekAtLastError();
    if (le != hipSuccess) fprintf(stderr, "kernel_launch: launch failed: %s\n", hipGetErrorName(le));
}
```
